# Optimizing an MI355X kernel written in HIP

```python
import math
import jax, jax.numpy as jnp
from jax import lax
import numpy as np

D_MODEL = 2048
BATCH = 2
SEQ = 8192
DEPTH = 1

N_META = 16
D_MIX = D_MODEL
D_LRU = D_MIX // 2
D_ATT = D_MIX - D_LRU
LRU_BLOCKS = 16
LRU_BLOCK_DIM = D_LRU // LRU_BLOCKS
CONV_WIDTH = 4
LRU_C = 8.0
N_HEADS = 8
V_HEAD_DIM = D_ATT // N_HEADS
QK_HEAD_DIM = V_HEAD_DIM // 2
N_BUCKETS = 32
MAX_DISTANCE = 128
Q_BLOCK = 128
N_GROUPS = 4
EXPERTS_PER_GROUP = 8
N_EXPERTS = N_GROUPS * EXPERTS_PER_GROUP
TOP_K = 2
D_EXPERT = D_MODEL // 2
DISPATCH_BLOCK = 128
D_IN_PROJ = 2 * D_LRU + 3 * D_ATT
EPS = 1e-6

kernel_name = "hymba_rglru_diffattn_hiermoe"


def rmsnorm(x, g):
    xf = x.astype(jnp.float32)
    y = xf * lax.rsqrt(jnp.mean(xf * xf, axis=-1, keepdims=True) + EPS)
    return (y * g.astype(jnp.float32)).astype(x.dtype)


def causal_depthwise_conv(x, w, b):
    T = x.shape[1]
    xp = jnp.pad(x, ((0, 0), (CONV_WIDTH - 1, 0), (0, 0)))
    return sum((xp[:, k:k + T] * w[k] for k in range(CONV_WIDTH)), b)


def rglru(x, w_r, b_r, w_i, b_i, lam):
    B, T, C = x.shape
    xb = x.reshape(B, T, LRU_BLOCKS, LRU_BLOCK_DIM)
    r = jax.nn.sigmoid(jnp.einsum('bthi,hij->bthj', xb, w_r) + b_r).reshape(B, T, C)
    i = jax.nn.sigmoid(jnp.einsum('bthi,hij->bthj', xb, w_i) + b_i).reshape(B, T, C)
    log_a = (LRU_C * r.astype(jnp.float32)) * jax.nn.log_sigmoid(lam.astype(jnp.float32))
    a = jnp.exp(log_a)
    bx = jnp.sqrt(-jnp.expm1(2.0 * log_a)) * (i * x).astype(jnp.float32)

    def combine(left, right):
        a_l, b_l = left
        a_r, b_r2 = right
        return a_l * a_r, a_r * b_l + b_r2

    _, h = lax.associative_scan(combine, (a, bx), axis=1)
    return h.astype(x.dtype)


def t5_bucket(rel):
    n = jnp.maximum(rel, 0)
    max_exact = N_BUCKETS // 2
    nf = jnp.maximum(n, 1).astype(jnp.float32)
    large = max_exact + (jnp.log(nf / max_exact) / math.log(MAX_DISTANCE / max_exact)
                         * (N_BUCKETS - max_exact)).astype(jnp.int32)
    large = jnp.minimum(large, N_BUCKETS - 1)
    return jnp.where(n < max_exact, n, large)


def diff_attention(q, k, v, rel_bias, lq1, lk1, lq2, lk2, subln_g, lambda_init):
    B, T, _ = q.shape
    T_pad = -(-T // Q_BLOCK) * Q_BLOCK
    n_blk = T_pad // Q_BLOCK
    pad = lambda t: jnp.pad(t, ((0, 0), (0, T_pad - T), (0, 0)))
    q = pad(q).reshape(B, T_pad, N_HEADS, 2, QK_HEAD_DIM).transpose(3, 0, 2, 1, 4)
    k = pad(k).reshape(B, T_pad, N_HEADS, 2, QK_HEAD_DIM).transpose(3, 0, 2, 1, 4)
    v = pad(v).reshape(B, T_pad, N_HEADS, V_HEAD_DIM).transpose(0, 2, 1, 3)
    q_blocks = q.reshape(2, B, N_HEADS, n_blk, Q_BLOCK, QK_HEAD_DIM).transpose(3, 0, 1, 2, 4, 5)
    lam = (jnp.exp(jnp.sum(lq1.astype(jnp.float32) * lk1.astype(jnp.float32)))
           - jnp.exp(jnp.sum(lq2.astype(jnp.float32) * lk2.astype(jnp.float32))) + lambda_init)
    k_pos = jnp.arange(T_pad, dtype=jnp.int32)
    scale = QK_HEAD_DIM ** -0.5

    def one_block(args):
        qb, blk = args
        q_pos = blk * Q_BLOCK + jnp.arange(Q_BLOCK, dtype=jnp.int32)
        rel = q_pos[:, None] - k_pos[None, :]
        bias = rel_bias[t5_bucket(rel)].astype(jnp.float32).transpose(2, 0, 1)
        s = jnp.einsum('mbhqd,mbhkd->mbhqk', qb, k).astype(jnp.float32) * scale + bias
        s = jnp.where(rel >= 0, s, -jnp.inf)
        p = jax.nn.softmax(s, axis=-1)
        w = p[0] - lam * p[1]
        return jnp.einsum('bhqk,bhkd->bhqd', w.astype(v.dtype), v)

    o = lax.map(one_block, (q_blocks, jnp.arange(n_blk, dtype=jnp.int32)))
    o = o.transpose(1, 2, 0, 3, 4).reshape(B, N_HEADS, T_pad, V_HEAD_DIM)[:, :, :T]
    o = rmsnorm(o, subln_g) * (1.0 - lambda_init)
    return o.transpose(0, 2, 1, 3).reshape(B, T, D_ATT)


def hier_moe(u, w_group, b_group, w_router, b_router, w_gate, w_up, w_down):
    B, T, D = u.shape
    n_tok = B * T
    xt = u.reshape(n_tok, D)
    g_logits = (xt @ w_group).astype(jnp.float32) + b_group.astype(jnp.float32)
    g_prob = jax.nn.softmax(g_logits, axis=-1)
    grp = jnp.argmax(g_logits, axis=-1).astype(jnp.int32)
    p_grp = jnp.take_along_axis(g_prob, grp[:, None], axis=-1)
    e_logits = ((xt @ w_router).astype(jnp.float32) + b_router.astype(jnp.float32)).reshape(
        n_tok, N_GROUPS, EXPERTS_PER_GROUP)
    e_in = jnp.take_along_axis(e_logits, grp[:, None, None], axis=1)[:, 0]
    top_v, top_i = lax.top_k(e_in, TOP_K)
    gates = (p_grp * jax.nn.softmax(top_v, axis=-1)).reshape(-1)
    expert = (grp[:, None] * EXPERTS_PER_GROUP + top_i.astype(jnp.int32)).reshape(-1)

    n_assign = n_tok * TOP_K
    tok = jnp.repeat(jnp.arange(n_tok, dtype=jnp.int32), TOP_K)
    order = jnp.argsort(expert)
    e_s, tok_s, gate_s = expert[order], tok[order], gates[order]
    counts = jax.ops.segment_sum(jnp.ones_like(expert), expert, num_segments=N_EXPERTS)
    starts = jnp.cumsum(counts) - counts
    padded = (counts + DISPATCH_BLOCK - 1) // DISPATCH_BLOCK * DISPATCH_BLOCK
    pends = jnp.cumsum(padded)
    pstarts = pends - padded
    dest = pstarts[e_s] + jnp.arange(n_assign, dtype=jnp.int32) - starts[e_s]
    n_blocks = -(-(n_assign + N_EXPERTS * (DISPATCH_BLOCK - 1)) // DISPATCH_BLOCK)
    rows = n_blocks * DISPATCH_BLOCK
    buf_tok = jnp.full((rows,), n_tok, dtype=jnp.int32).at[dest].set(tok_s)
    x_buf = jnp.concatenate([xt, jnp.zeros((1, D), xt.dtype)], axis=0)[buf_tok]
    x_buf = x_buf.reshape(n_blocks, DISPATCH_BLOCK, D)
    blk_start = jnp.arange(n_blocks, dtype=jnp.int32) * DISPATCH_BLOCK
    blk_expert = jnp.minimum(jnp.searchsorted(pends, blk_start, side='right'), N_EXPERTS - 1)

    def expert_block(args):
        xb, e = args
        return (jax.nn.silu(xb @ w_gate[e]) * (xb @ w_up[e])) @ w_down[e]

    y_buf = lax.map(expert_block, (x_buf, blk_expert)).reshape(rows, D)
    y_assign = y_buf[dest] * gate_s[:, None].astype(u.dtype)
    y = jax.ops.segment_sum(y_assign, tok_s, num_segments=n_tok)
    return y.reshape(B, T, D)


def setup_inputs(seed: int = 0) -> dict:
    key = jax.random.key(seed)
    ks = jax.random.split(key, 27)
    f32 = jnp.float32
    nrm = lambda k, shape, s: jax.random.normal(k, shape, f32) * s
    a0 = jax.random.uniform(ks[10], (DEPTH, D_LRU), f32, 0.9, 0.999)
    sig = a0 ** (1.0 / LRU_C)
    lru_L = jnp.log(sig) - jnp.log1p(-sig)
    return {
        "x": nrm(ks[0], (BATCH, SEQ, D_MODEL), 1.0),
        "meta_tokens": nrm(ks[1], (N_META, D_MODEL), 1.0),
        "g_mix": 1.0 + nrm(ks[2], (DEPTH, D_MODEL), 0.01),
        "w_in": nrm(ks[3], (DEPTH, D_MODEL, D_IN_PROJ), D_MODEL ** -0.5),
        "conv_w": nrm(ks[4], (DEPTH, CONV_WIDTH, D_LRU), CONV_WIDTH ** -0.5),
        "conv_b": nrm(ks[5], (DEPTH, D_LRU), 0.01),
        "w_rgate": nrm(ks[6], (DEPTH, LRU_BLOCKS, LRU_BLOCK_DIM, LRU_BLOCK_DIM), LRU_BLOCK_DIM ** -0.5),
        "b_rgate": nrm(ks[7], (DEPTH, LRU_BLOCKS, LRU_BLOCK_DIM), 0.01),
        "w_igate": nrm(ks[8], (DEPTH, LRU_BLOCKS, LRU_BLOCK_DIM, LRU_BLOCK_DIM), LRU_BLOCK_DIM ** -0.5),
        "b_igate": nrm(ks[9], (DEPTH, LRU_BLOCKS, LRU_BLOCK_DIM), 0.01),
        "lru_L": lru_L,
        "lambda_q1": nrm(ks[11], (DEPTH, QK_HEAD_DIM), 0.1),
        "lambda_k1": nrm(ks[12], (DEPTH, QK_HEAD_DIM), 0.1),
        "lambda_q2": nrm(ks[13], (DEPTH, QK_HEAD_DIM), 0.1),
        "lambda_k2": nrm(ks[14], (DEPTH, QK_HEAD_DIM), 0.1),
        "subln_g": 1.0 + nrm(ks[15], (DEPTH, V_HEAD_DIM), 0.01),
        "rel_bias": nrm(ks[16], (N_BUCKETS, N_HEADS), 0.5),
        "w_out": nrm(ks[17], (DEPTH, D_MIX, D_MODEL), D_MIX ** -0.5),
        "g_ffn": 1.0 + nrm(ks[18], (DEPTH, D_MODEL), 0.01),
        "w_group": nrm(ks[19], (DEPTH, D_MODEL, N_GROUPS), D_MODEL ** -0.5),
        "b_group": nrm(ks[20], (DEPTH, N_GROUPS), 0.01),
        "w_router": nrm(ks[21], (DEPTH, D_MODEL, N_EXPERTS), D_MODEL ** -0.5),
        "b_router": nrm(ks[22], (DEPTH, N_EXPERTS), 0.01),
        "w_gate": nrm(ks[23], (DEPTH, N_EXPERTS, D_MODEL, D_EXPERT), D_MODEL ** -0.5),
        "w_up": nrm(ks[24], (DEPTH, N_EXPERTS, D_MODEL, D_EXPERT), D_MODEL ** -0.5),
        "w_down": nrm(ks[25], (DEPTH, N_EXPERTS, D_EXPERT, D_MODEL), D_EXPERT ** -0.5),
        "g_final": 1.0 + nrm(ks[26], (D_MODEL,), 0.01),
    }


def reference(x, meta_tokens, g_mix, w_in, conv_w, conv_b, w_rgate, b_rgate, w_igate, b_igate,
              lru_L, lambda_q1, lambda_k1, lambda_q2, lambda_k2, subln_g, rel_bias, w_out,
              g_ffn, w_group, b_group, w_router, b_router, w_gate, w_up, w_down, g_final):
    B = x.shape[0]
    meta = jnp.broadcast_to(meta_tokens[None].astype(x.dtype), (B, N_META, D_MODEL))
    h = jnp.concatenate([meta, x], axis=1)
    splits = [D_LRU, 2 * D_LRU, 2 * D_LRU + D_ATT, 2 * D_LRU + 2 * D_ATT]
    for l in range(DEPTH):
        lambda_init = 0.8 - 0.6 * math.exp(-0.3 * l)
        u = rmsnorm(h, g_mix[l])
        proj = u @ w_in[l]
        x_lru, g_lru, q, k, v = jnp.split(proj, splits, axis=-1)
        y_lru = rglru(causal_depthwise_conv(x_lru, conv_w[l], conv_b[l]),
                      w_rgate[l], b_rgate[l], w_igate[l], b_igate[l], lru_L[l]) * jax.nn.gelu(g_lru)
        y_att = diff_attention(q, k, v, rel_bias, lambda_q1[l], lambda_k1[l], lambda_q2[l],
                               lambda_k2[l], subln_g[l], lambda_init)
        h = h + jnp.concatenate([y_lru, y_att], axis=-1) @ w_out[l]
        h = h + hier_moe(rmsnorm(h, g_ffn[l]), w_group[l], b_group[l], w_router[l], b_router[l],
                         w_gate[l], w_up[l], w_down[l])
    h = rmsnorm(h, g_final)
    return h[:, N_META:]
```

```cpp
#define MK_STAGE 5
#define MK_ONE_LAUNCH 1
#define MK_REPEAT -1
#include <hip/hip_runtime.h>
#include <hip/hip_bf16.h>
#include <stdint.h>
#include <math.h>

namespace mk {
#define LAS __attribute__((address_space(3)))
#define GAS __attribute__((address_space(1)))
typedef unsigned short bf16_t;
typedef short bf16x8 __attribute__((ext_vector_type(8)));
typedef float f32x4 __attribute__((ext_vector_type(4)));
typedef float f32x2 __attribute__((ext_vector_type(2)));
typedef float f32x16 __attribute__((ext_vector_type(16)));
typedef unsigned u32x4 __attribute__((ext_vector_type(4)));
typedef unsigned u32x2 __attribute__((ext_vector_type(2)));
typedef int i32x4 __attribute__((ext_vector_type(4)));
typedef int i32x8 __attribute__((ext_vector_type(8)));
typedef GAS unsigned gu32;

constexpr int NB = 2, SEQ = 8192, NMETA = 16, D = 2048, M = NB * SEQ;
constexpr int TPAD = 64, TP = SEQ + TPAD, MP = NB * TP;
constexpr int DIN = 5120, DLRU = 1024, DATT = 1024, NH = 8, NE = 32, DE = 1024, NLB = 16;
constexpr int ECAP = M;
constexpr int MAXROWS = 40960;
constexpr float EPS = 1e-6f;
constexpr float LOG2E = 1.4426950408889634f;
constexpr float C2 = 0.125f * LOG2E;
constexpr float WSCALE8 = 64.f;
constexpr int LCH = 128, NCH = SEQ / LCH;

constexpr size_t MiB = 1u << 20;
constexpr size_t WS_CTL = 0, CTL_ZERO_BYTES = 1 * MiB;
constexpr size_t WS_SMALL = 1 * MiB;
constexpr size_t WS_WIN = 17 * MiB;
constexpr size_t WS_WOUT = 37 * MiB;
constexpr size_t WS_WGU = 45 * MiB;
constexpr size_t WS_WD = 301 * MiB;
constexpr size_t WS_XN = 429 * MiB;
constexpr size_t WS_PROJ = 493 * MiB;
constexpr size_t PROJ_TSTRIDE = 33 * MiB;
constexpr size_t WS_OALL = 658 * MiB;
constexpr size_t WS_MIX = 722 * MiB;
constexpr size_t WS_H = 786 * MiB;
constexpr size_t WS_U2 = 850 * MiB;
constexpr size_t WS_END = 914 * MiB;
static_assert((size_t)MP * 1024 * 2 <= PROJ_TSTRIDE && (size_t)MAXROWS * 2048 * 2 <= 5 * PROJ_TSTRIDE && (size_t)MAXROWS * 1024 * 2 <= 128 * MiB, "ws map");
constexpr size_t SM_BIAS = 0;
constexpr size_t SM_WG36 = 64 * 1024;
constexpr size_t SM_XNM = 512 * 1024;
constexpr size_t SM_LRUTOT = 1 * MiB;
constexpr size_t SM_PERM = 2 * MiB;
constexpr size_t SM_RSTD = 4 * MiB;
constexpr size_t SM_GATE = 6 * MiB;
constexpr size_t SM_TOKE = 8 * MiB;
constexpr size_t SM_TOKS = 8 * MiB + 256 * 1024;
constexpr size_t SM_XRMS = 9 * MiB;
constexpr size_t SM_GINV = 9 * MiB + 64 * 1024;
constexpr int CW_TMO = 0, CW_CODE = 1, CW_CNT = 64  , CW_DONE = 1024  , CW_LRU1 = 2048  , CW_BAR = 4096;

#define RLX_AGENT __ATOMIC_RELAXED, __HIP_MEMORY_SCOPE_AGENT
#define LDS_WAIT() asm volatile("s_waitcnt lgkmcnt(0)" ::: "memory")
#define VM_WAIT() asm volatile("s_waitcnt vmcnt(0)" ::: "memory")
__device__ __forceinline__ unsigned f2bf(float f) { unsigned u = __builtin_bit_cast(unsigned, f); return (u + 0x7fffu + ((u >> 16) & 1u)) >> 16; }
__device__ __forceinline__ unsigned pk2(float lo, float hi) { return f2bf(lo) | (f2bf(hi) << 16); }
__device__ __forceinline__ float bf2f(unsigned short v) { return __builtin_bit_cast(float, (unsigned)v << 16); }
__device__ __forceinline__ float bflo(unsigned v) { return __builtin_bit_cast(float, v << 16); }
__device__ __forceinline__ float bfhi(unsigned v) { return __builtin_bit_cast(float, v & 0xffff0000u); }
__device__ __forceinline__ unsigned cvt_pk_bf16(float lo, float hi) { unsigned r; asm volatile("v_cvt_pk_bf16_f32 %0, %1, %2" : "=v"(r) : "v"(lo), "v"(hi)); return r; }
__device__ __forceinline__ unsigned pk4_fp8(float a, float b, float c, float d) { unsigned w = 0u; w = (unsigned)__builtin_amdgcn_cvt_pk_fp8_f32(a, b, (int)w, false); w = (unsigned)__builtin_amdgcn_cvt_pk_fp8_f32(c, d, (int)w, true); return w; }
__device__ __forceinline__ float wave_sum(float v) {
#pragma unroll
    for (int o = 1; o < 64; o <<= 1) v += __shfl_xor(v, o);
    return v;
}

#define XB_TMO      128
#define XB_XCNT(j)  (256  + 64 * (j))
#define XB_XSUB(j)  (1280 + 64 * (j))
#define XB_XGEN(j)  (2304 + 64 * (j))
#define XB_TOP      3328
#define XB_TOPGEN   3392
#define XCD_BAR_WORDS 3456
#define XB_SPIN_CAP (1u << 18)
__device__ __forceinline__ unsigned xb_ld(unsigned* p)              { return __hip_atomic_load(p, __ATOMIC_RELAXED, __HIP_MEMORY_SCOPE_AGENT); }
__device__ __forceinline__ unsigned xb_add(unsigned* p, unsigned v) { return __hip_atomic_fetch_add(p, v, __ATOMIC_RELAXED, __HIP_MEMORY_SCOPE_AGENT); }
__device__ __forceinline__ unsigned xb_xcc_id() { return (unsigned)__builtin_amdgcn_s_getreg((3 << 11) | 20) & 0xFu; }
#define XB_SPIN(cond, bar) do { unsigned _sp = 0; while (cond) { __builtin_amdgcn_s_sleep(1); \
    if ((++_sp & 255u) == 0u) { if (xb_ld(&(bar)[XB_TMO])) break; if (_sp > XB_SPIN_CAP) { atomicAdd(&(bar)[XB_TMO], 1u); break; } } } } while (0)
struct XcdBarrier { unsigned* bar; unsigned x; volatile LAS unsigned* st; };
__device__ __forceinline__ XcdBarrier xcd_barrier_post(unsigned* bar, volatile LAS unsigned* st) {
    XcdBarrier b; b.bar = bar; b.x = xb_xcc_id(); b.st = st;
    if (threadIdx.x == 0) (void)xb_add(&bar[XB_XCNT(b.x)], 1u);
    return b;
}
__device__ __forceinline__ void xcd_barrier_complete(unsigned* bar, unsigned x, unsigned& nloc, unsigned& nx) {
    const unsigned G = gridDim.x * gridDim.y * gridDim.z;
    unsigned sum, cnt, mine, sp = 0u;
    for (;;) {
        sum = 0u; cnt = 0u; mine = 0u;
#pragma unroll
        for (unsigned j = 0; j < 16; ++j) { const unsigned c = xb_ld(&bar[XB_XCNT(j)]); sum += c; cnt += (c > 0u) ? 1u : 0u; mine = (j == x) ? c : mine; }
        if (sum == G) break;
        __builtin_amdgcn_s_sleep(1);
        if ((++sp & 255u) == 0u) { if (xb_ld(&bar[XB_TMO])) break; if (sp > XB_SPIN_CAP) { atomicAdd(&bar[XB_TMO], 1u); break; } }
    }
    nloc = mine > 0u ? mine : 1u; nx = cnt > 0u ? cnt : 1u;
}
__device__ __forceinline__ void xcd_barrier(const XcdBarrier& b) {
    asm volatile("s_waitcnt vmcnt(0)" ::: "memory");
    __syncthreads();
    if (threadIdx.x == 0) {
        unsigned* bar = b.bar;
        __builtin_amdgcn_s_waitcnt(0);
        unsigned nloc = b.st[0], nx = b.st[1];
        if (nloc == 0u) { xcd_barrier_complete(bar, b.x, nloc, nx); b.st[0] = nloc; b.st[1] = nx; }
        const unsigned old = xb_add(&bar[XB_XSUB(b.x)], 1u);
        const unsigned gen = old / nloc;
        if (old + 1u == (gen + 1u) * nloc) {
            __builtin_amdgcn_fence(__ATOMIC_RELEASE, "agent");
            asm volatile("s_waitcnt vmcnt(0)" ::: "memory");
            const unsigned og = xb_add(&bar[XB_TOP], 1u);
            const unsigned tg = og / nx;
            if (og + 1u == (tg + 1u) * nx) xb_add(&bar[XB_TOPGEN], 1u);
            else XB_SPIN(xb_ld(&bar[XB_TOPGEN]) == tg, bar);
            __builtin_amdgcn_fence(__ATOMIC_ACQUIRE, "agent");
            xb_add(&bar[XB_XGEN(b.x)], 1u);
            asm volatile("s_waitcnt vmcnt(0)" ::: "memory");
        } else {
            XB_SPIN(xb_ld(&bar[XB_XGEN(b.x)]) == gen, bar);
            __builtin_amdgcn_fence(__ATOMIC_ACQUIRE, "agent");
            asm volatile("s_waitcnt vmcnt(0)" ::: "memory");
        }
    }
    __syncthreads();
}

namespace pg8 {
constexpr int BM = 256, BK = 64, HALF = 128, HTB = HALF * BK * 2, STAGE_BYTES = 8 * HTB, NXCD = 8, WGM = 8;
__host__ __device__ __forceinline__ int lds_byte(int r, int c) { const int st = (r >> 4) * 2 + (c >> 5), rr = r & 15, cc = c & 31, ob = rr * 64 + cc * 2; return st * 1024 + (ob ^ (((ob >> 9) & 1) << 5)); }
__host__ __device__ __forceinline__ void stage_rc(int b, int& R, int& C) { const int st = b / 1024, sb = b % 1024, swz = sb ^ (((sb >> 9) & 1) << 5); R = (st >> 1) * 16 + swz / 64; C = (st & 1) * 32 + (swz % 64) / 2; }
__host__ __device__ __forceinline__ int perm32(int rho) { const int n = rho >> 4, i = rho & 15; return 8 * (i >> 2) + 4 * n + (i & 3); }

struct Unit { int pm, pn, e, rows, r0, rowbase, half, dep; };

struct Dense {
    static constexpr bool WAITS = false;
    const bf16_t* A; const bf16_t* Bt; int KB  ; int nM, nN, nwg, G, c, wgm;
    __device__ void init(const bf16_t* A_, const bf16_t* Bt_, int M_, int N_, int K_, int G_, int c_) { A = A_; Bt = Bt_; KB = 2 * K_; nM = M_ / BM; nN = N_ / BM; nwg = nM * nN; G = G_; c = c_; wgm = WGM; }
    __device__ bool next(int i, Unit& u) const {
        const long L = (long)i * G + c; if (L >= nwg) return false;
        int wgid = (int)L; { const int q = nwg / NXCD, r = nwg % NXCD, xcd = wgid % NXCD, off = wgid / NXCD; wgid = (xcd < r ? xcd * (q + 1) : r * (q + 1) + (xcd - r) * q) + off; }
        const int nig = wgm * nN, gid = wgid / nig, fm = gid * wgm, gsz = (nM - fm) < wgm ? (nM - fm) : wgm;
        u.pm = fm + ((wgid % nig) % gsz); u.pn = (wgid % nig) / gsz; u.e = 0; u.rows = BM; u.r0 = 0; u.rowbase = u.pm * BM; u.half = 0; u.dep = 0; return true;
    }
    __device__ __forceinline__ const void* a_ptr() const { return A; }
    __device__ __forceinline__ const void* b_ptr() const { return Bt; }
    __device__ __forceinline__ unsigned a_soff(const Unit& u) const { return (unsigned)u.pm * (2u * (unsigned)HALF * (unsigned)KB); }
    __device__ __forceinline__ unsigned b_soff(const Unit& u) const { return (unsigned)u.pn * (2u * (unsigned)HALF * (unsigned)KB); }
    __device__ __forceinline__ void a_off(const Unit&, const unsigned (&vA)[2], const int (&)[2], const int (&)[2], unsigned (&o)[2][2]) const {
        const unsigned hs = (unsigned)HALF * (unsigned)KB; o[0][0] = vA[0]; o[0][1] = vA[1]; o[1][0] = vA[0] + hs; o[1][1] = vA[1] + hs; }
};

template <class Epi, class Prob, bool ALIGN_EPI, bool FP8 = false>
__device__ __forceinline__ void gemm_phase(LAS unsigned char* lds, const Prob& S, const Epi& E) {
    int tid_ = threadIdx.x; asm volatile("" : "+v"(tid_));
    const int tid = tid_, wid = __builtin_amdgcn_readfirstlane(tid >> 6), lane = tid & 63, wr = wid >> 2, wc = wid & 3, fr = lane & 15, fq = lane >> 4;
    const int KB = S.KB, nt = KB / (BK * 2);
    unsigned voffA[2], voffB[2]; int stR[2], stC[2];
#pragma unroll
    for (int i = 0; i < 2; ++i) { int R, C; stage_rc(tid * 16 + i * 8192, R, C); const int Rb = Epi::PERM ? ((R & ~31) + perm32(R & 31)) : R; stR[i] = R; stC[i] = C;
        voffA[i] = (unsigned)(R * KB + C * 2); voffB[i] = (unsigned)(Rb * KB + C * 2); }
    const unsigned kstep = (unsigned)(BK * 2);
    const unsigned hstep = (unsigned)HALF * (unsigned)KB;
    const __amdgpu_buffer_rsrc_t RA = __builtin_amdgcn_make_buffer_rsrc((void*)S.a_ptr(), 0, 0x7fffffff, 0x00020000), RB = __builtin_amdgcn_make_buffer_rsrc((void*)S.b_ptr(), 0, 0x7fffffff, 0x00020000);
    const unsigned ldsw = (unsigned)wid * 1024u;
    const int aoff = lds_byte(wr * 64 + fr, fq * 8), boff = lds_byte(wc * 32 + fr, fq * 8);
#define PG8_SA(b, h) (((b) * 2 + (h)) * HTB)
#define PG8_SB(b, h) ((4 + (b) * 2 + (h)) * HTB)
#define PG8_STAGE2(bufoff, rs, so, v0, v1) do { \
        __builtin_amdgcn_raw_ptr_buffer_load_lds(rs, (LAS void*)(lds + (bufoff) + ldsw), 16, (int)(v0), (int)(so), 0, 0); \
        __builtin_amdgcn_raw_ptr_buffer_load_lds(rs, (LAS void*)(lds + (bufoff) + ldsw + 8192), 16, (int)(v1), (int)(so), 0, 0); } while (0)
#ifndef MK_BAUX
#define MK_BAUX 0
#endif
#define PG8_STAGEB(bufoff, so) do { \
        __builtin_amdgcn_raw_ptr_buffer_load_lds(RB, (LAS void*)(lds + (bufoff) + ldsw), 16, (int)(voffB[0]), (int)(so), 0, FP8 ? MK_BAUX : 0); \
        __builtin_amdgcn_raw_ptr_buffer_load_lds(RB, (LAS void*)(lds + (bufoff) + ldsw + 8192), 16, (int)(voffB[1]), (int)(so), 0, FP8 ? MK_BAUX : 0); } while (0)
#define PG8_CAT(x_, y_) __builtin_shufflevector((x_), (y_), 0, 1, 2, 3, 4, 5, 6, 7)
#define PG8_LDA(dst, b, h) do { if constexpr (FP8) { _Pragma("unroll") for (int m = 0; m < 4; ++m) dst##8[m] = PG8_CAT(*(const LAS i32x4*)(lds + PG8_SA(b, h) + aoff + m * 2048), *(const LAS i32x4*)(lds + PG8_SA(b, h) + aoff + m * 2048 + 1024)); } \
        else { _Pragma("unroll") for (int m = 0; m < 4; ++m) _Pragma("unroll") for (int k = 0; k < 2; ++k) dst[m][k] = *(const LAS bf16x8*)(lds + PG8_SA(b, h) + aoff + m * 2048 + k * 1024); } } while (0)
#define PG8_LDB(dst, b, h) do { if constexpr (FP8) { _Pragma("unroll") for (int n = 0; n < 2; ++n) dst##8[n] = PG8_CAT(*(const LAS i32x4*)(lds + PG8_SB(b, h) + boff + n * 2048), *(const LAS i32x4*)(lds + PG8_SB(b, h) + boff + n * 2048 + 1024)); } \
        else { _Pragma("unroll") for (int n = 0; n < 2; ++n) _Pragma("unroll") for (int k = 0; k < 2; ++k) dst[n][k] = *(const LAS bf16x8*)(lds + PG8_SB(b, h) + boff + n * 2048 + k * 1024); } } while (0)
#define PG8_MMA(ai, bj, At, Bt) do { __builtin_amdgcn_s_setprio(1); \
        if constexpr (FP8) { _Pragma("unroll") for (int m = 0; m < 4; ++m) _Pragma("unroll") for (int n = 0; n < 2; ++n)   \
            asm volatile("v_mfma_scale_f32_16x16x128_f8f6f4 %0, %1, %2, %0, %3, %3 op_sel_hi:[0,0,0]" : "+v"(acc[ai][bj][m][n]) : "v"(Bt##8[n]), "v"(At##8[m]), "v"(sc1)); } \
        else { _Pragma("unroll") for (int m = 0; m < 4; ++m) _Pragma("unroll") for (int n = 0; n < 2; ++n) _Pragma("unroll") for (int k = 0; k < 2; ++k) \
            acc[ai][bj][m][n] = __builtin_amdgcn_mfma_f32_16x16x32_bf16(Bt[n][k], At[m][k], acc[ai][bj][m][n], 0, 0, 0); } \
        __builtin_amdgcn_s_setprio(0); } while (0)
#define PG8_WAIT_V(n) asm volatile("s_waitcnt vmcnt(" #n ")" ::: "memory")
#define PG8_WAIT_L(n) asm volatile("s_waitcnt lgkmcnt(" #n ")" ::: "memory")
#define PG8_BAR __builtin_amdgcn_s_barrier()
#define PG8_SCHED __builtin_amdgcn_sched_barrier(0)
    Unit cur, nxt; int ui = 0;
    if (!S.next(0, cur)) return;
    int wstate = 0;
    if constexpr (Prob::WAITS) S.wait_sync(cur, wstate);
    bool pend = false; int pend_e = 0;
    f32x4 acc[2][2][4][2];
#pragma unroll
    for (int a = 0; a < 2; ++a)
#pragma unroll
        for (int b = 0; b < 2; ++b)
#pragma unroll
            for (int m = 0; m < 4; ++m)
#pragma unroll
                for (int n = 0; n < 2; ++n) acc[a][b][m][n] = (f32x4){0.f, 0.f, 0.f, 0.f};
    unsigned sc1 = 0x7f7f7f7fu; asm volatile("" : "+v"(sc1));
    bf16x8 At[4][2], B0[2][2], B1[2][2]; i32x8 At8[4], B08[2], B18[2];
    unsigned cA = (unsigned)__builtin_amdgcn_readfirstlane((int)S.a_soff(cur)), cB = (unsigned)__builtin_amdgcn_readfirstlane((int)S.b_soff(cur));
    unsigned cO[2][2], nO[2][2];
    S.a_off(cur, voffA, stR, stC, cO);
    PG8_STAGEB(PG8_SB(0, 0), cB); PG8_STAGEB(PG8_SB(0, 1), cB + hstep); PG8_STAGE2(PG8_SA(0, 0), RA, cA, cO[0][0], cO[0][1]); PG8_STAGE2(PG8_SA(0, 1), RA, cA, cO[1][0], cO[1][1]);
    if (wr == 1) PG8_BAR;
    PG8_WAIT_V(2); PG8_BAR;
    PG8_STAGEB(PG8_SB(1, 0), cB + kstep); PG8_STAGE2(PG8_SA(1, 0), RA, cA + kstep, cO[0][0], cO[0][1]); PG8_STAGEB(PG8_SB(1, 1), cB + hstep + kstep);
    PG8_WAIT_V(6); PG8_BAR;
    for (;;) {
        const bool has_next = S.next(ui + 1, nxt);
        if constexpr (Prob::WAITS) { if (has_next) S.wait_sync(nxt, wstate); }
        unsigned nA = cA, nB = cB;
        if (has_next) { nA = (unsigned)__builtin_amdgcn_readfirstlane((int)S.a_soff(nxt)); nB = (unsigned)__builtin_amdgcn_readfirstlane((int)S.b_soff(nxt)); }
        nO[0][0] = cO[0][0]; nO[0][1] = cO[0][1]; nO[1][0] = cO[1][0]; nO[1][1] = cO[1][1];
        float pre[8];
#pragma unroll
        for (int q = 0; q < 8; ++q) pre[q] = 0.f;
        for (int t = 0; t < nt; t += 2) {
            const bool last = (t == nt - 2);
            if (has_next && t == nt - 4) S.a_off(nxt, voffA, stR, stC, nO);
            if (last) { int l1 = (int)__builtin_amdgcn_mbcnt_hi(~0u, __builtin_amdgcn_mbcnt_lo(~0u, 0u)); asm volatile("" : "+v"(l1)); E.prefetch(cur, wr, l1 & 15, pre); }
            const unsigned a1 = cA + (unsigned)(t + 1) * kstep;
            const unsigned a2 = last ? nA : cA + (unsigned)(t + 2) * kstep, b2 = last ? nB : cB + (unsigned)(t + 2) * kstep;
            const unsigned a3 = a2 + kstep, b3 = b2 + kstep;
            const unsigned s00 = last ? nO[0][0] : cO[0][0], s01 = last ? nO[0][1] : cO[0][1], s10 = last ? nO[1][0] : cO[1][0], s11 = last ? nO[1][1] : cO[1][1];
            PG8_LDB(B0, 0, 0); PG8_LDB(B1, 0, 1); PG8_SCHED; PG8_LDA(At, 0, 0); PG8_STAGE2(PG8_SA(1, 1), RA, a1, cO[1][0], cO[1][1]);
            PG8_WAIT_V(8); PG8_WAIT_L(0); PG8_BAR; PG8_MMA(0, 0, At, B0); PG8_MMA(0, 1, At, B1); PG8_BAR; PG8_SCHED;
            PG8_LDA(At, 0, 1); PG8_STAGEB(PG8_SB(0, 0), b2); PG8_STAGEB(PG8_SB(0, 1), b2 + hstep); PG8_STAGE2(PG8_SA(0, 0), RA, a2, s00, s01);
            PG8_WAIT_V(8); PG8_WAIT_L(0); PG8_BAR; PG8_MMA(1, 0, At, B0); PG8_MMA(1, 1, At, B1); PG8_BAR; PG8_SCHED;
            PG8_LDB(B0, 1, 0); PG8_LDB(B1, 1, 1); PG8_SCHED; PG8_LDA(At, 1, 0); PG8_STAGE2(PG8_SA(0, 1), RA, a2, s10, s11);
            PG8_WAIT_V(8); PG8_WAIT_L(0); PG8_BAR; PG8_MMA(0, 0, At, B0); PG8_MMA(0, 1, At, B1); PG8_BAR; PG8_SCHED;
            PG8_LDA(At, 1, 1); PG8_STAGEB(PG8_SB(1, 0), b3); PG8_STAGEB(PG8_SB(1, 1), b3 + hstep); PG8_STAGE2(PG8_SA(1, 0), RA, a3, s00, s01);
            PG8_WAIT_V(8); PG8_WAIT_L(0); PG8_BAR; PG8_MMA(1, 0, At, B0); PG8_MMA(1, 1, At, B1); PG8_BAR; PG8_SCHED;
        }
        if constexpr (ALIGN_EPI) { if (wr == 0) PG8_BAR; }
        if constexpr (FP8) {
            asm volatile("s_nop 15\n\ts_nop 7" : "+v"(acc[0][0][0][0]), "+v"(acc[0][0][0][1]), "+v"(acc[0][0][1][0]), "+v"(acc[0][0][1][1]), "+v"(acc[0][0][2][0]), "+v"(acc[0][0][2][1]), "+v"(acc[0][0][3][0]), "+v"(acc[0][0][3][1]));
            asm volatile("" : "+v"(acc[0][1][0][0]), "+v"(acc[0][1][0][1]), "+v"(acc[0][1][1][0]), "+v"(acc[0][1][1][1]), "+v"(acc[0][1][2][0]), "+v"(acc[0][1][2][1]), "+v"(acc[0][1][3][0]), "+v"(acc[0][1][3][1]));
            asm volatile("" : "+v"(acc[1][0][0][0]), "+v"(acc[1][0][0][1]), "+v"(acc[1][0][1][0]), "+v"(acc[1][0][1][1]), "+v"(acc[1][0][2][0]), "+v"(acc[1][0][2][1]), "+v"(acc[1][0][3][0]), "+v"(acc[1][0][3][1]));
            asm volatile("" : "+v"(acc[1][1][0][0]), "+v"(acc[1][1][0][1]), "+v"(acc[1][1][1][0]), "+v"(acc[1][1][1][1]), "+v"(acc[1][1][2][0]), "+v"(acc[1][1][2][1]), "+v"(acc[1][1][3][0]), "+v"(acc[1][1][3][1]));
        }
        if constexpr (Epi::SIGNALS) { if (pend) { E.signal(pend_e); pend = false; } }
        { int l2 = (int)__builtin_amdgcn_mbcnt_hi(~0u, __builtin_amdgcn_mbcnt_lo(~0u, 0u)); asm volatile("" : "+v"(l2));
          E(acc, cur, wr, wc, l2 & 15, l2 >> 4, pre); }
#ifdef MK_EPI2
        asm volatile("" ::: "memory"); E(acc, cur, wr, wc, fr, fq, pre);
#endif
        if constexpr (Epi::SIGNALS) { pend = true; pend_e = cur.e; }
        if (!has_next) break;
#pragma unroll
        for (int a = 0; a < 2; ++a)
#pragma unroll
            for (int b = 0; b < 2; ++b)
#pragma unroll
                for (int m = 0; m < 4; ++m)
#pragma unroll
                    for (int n = 0; n < 2; ++n) acc[a][b][m][n] = (f32x4){0.f, 0.f, 0.f, 0.f};
        cur = nxt; cA = nA; cB = nB; ++ui;
        cO[0][0] = nO[0][0]; cO[0][1] = nO[0][1]; cO[1][0] = nO[1][0]; cO[1][1] = nO[1][1];
        if constexpr (ALIGN_EPI) { if (wr == 1) PG8_BAR; }
    }
    PG8_WAIT_V(0);
    if constexpr (!ALIGN_EPI) { if (wr == 0) PG8_BAR; }
    PG8_BAR;
    if constexpr (Epi::SIGNALS) { if (pend) E.signal(pend_e); }
#undef PG8_SA
#undef PG8_SB
#undef PG8_STAGE2
#undef PG8_STAGEB
#undef PG8_LDA
#undef PG8_LDB
#undef PG8_MMA
#undef PG8_CAT
#undef PG8_WAIT_V
#undef PG8_WAIT_L
#undef PG8_BAR
#undef PG8_SCHED
}
}
}
namespace mk {
struct Args { const float* in[27]; float* out; unsigned char* ws; int ph_lo, ph_hi; };

enum { I_X = 0, I_META, I_GMIX, I_WIN, I_CONVW, I_CONVB, I_WR, I_BR, I_WI, I_BI, I_LRUL, I_LQ1, I_LK1, I_LQ2, I_LK2, I_SUBLN, I_RELB, I_WOUT, I_GFFN, I_WGRP, I_BGRP, I_WRT, I_BRT, I_WGATE, I_WUP, I_WDOWN, I_GFINAL };

struct TItem { const float* src; bf16_t* dst; int N, K, k0, n0, rm; };
__device__ __forceinline__ int titem_row(int rm, int n) { return rm == 0 ? n : (n >= 2048 ? n - 2048 : n + 3072); }
__device__ __forceinline__ void titem_load(const TItem& t, int lane, f32x4 (&v)[8]) {
    const int kr = lane >> 3, c4 = (lane & 7) * 4;
#pragma unroll
    for (int i = 0; i < 8; ++i) v[i] = __builtin_nontemporal_load((const GAS f32x4*)(t.src + (size_t)(t.k0 + 8 * i + kr) * t.N + t.n0 + c4));
}
__device__ __forceinline__ void titem_store(const TItem& t, int lane, const f32x4 (&v)[8], LAS float* scr) {
    const int kr = lane >> 3, c4 = (lane & 7) * 4;
#pragma unroll
    for (int i = 0; i < 8; ++i) { LAS float* d = scr + (8 * i + kr) * 33 + c4; d[0] = v[i].x; d[1] = v[i].y; d[2] = v[i].z; d[3] = v[i].w; }
    LDS_WAIT(); asm volatile("" ::: "memory");
    const int c = lane & 7;
#pragma unroll
    for (int j = 0; j < 4; ++j) { const int n = (lane >> 3) + 8 * j; const LAS float* s = scr + (8 * c) * 33 + n;
        u32x4 o; o.x = cvt_pk_bf16(s[0 * 33], s[1 * 33]); o.y = cvt_pk_bf16(s[2 * 33], s[3 * 33]); o.z = cvt_pk_bf16(s[4 * 33], s[5 * 33]); o.w = cvt_pk_bf16(s[6 * 33], s[7 * 33]);
        *(GAS u32x4*)(t.dst + (size_t)titem_row(t.rm, t.n0 + n) * t.K + t.k0 + 8 * c) = o; }
    LDS_WAIT(); asm volatile("" ::: "memory");
}

__device__ __forceinline__ int titem8_row(int rm, int n) { return rm == 0 ? n : 256 * (n >> 7) + (n & 127) + (rm == 5 ? 128 : 0); }
__device__ __forceinline__ void titem8_load(const TItem& t, int lane, f32x4 (&v)[16]) {
    const int kr = lane >> 3, c4 = (lane & 7) * 4;
#pragma unroll
    for (int i = 0; i < 16; ++i) v[i] = __builtin_nontemporal_load((const GAS f32x4*)(t.src + (size_t)(t.k0 + 8 * i + kr) * t.N + t.n0 + c4));
}
__device__ __forceinline__ void titem8_store(const TItem& t, int lane, const f32x4 (&v)[16], LAS float* scr) {
    const int kr = lane >> 3, c4 = (lane & 7) * 4;
#pragma unroll
    for (int i = 0; i < 16; ++i) { LAS float* d = scr + (8 * i + kr) * 33 + c4; d[0] = v[i].x * WSCALE8; d[1] = v[i].y * WSCALE8; d[2] = v[i].z * WSCALE8; d[3] = v[i].w * WSCALE8; }
    LDS_WAIT(); asm volatile("" ::: "memory");
    const int c = lane & 7;
    unsigned char* dst = (unsigned char*)t.dst;
#pragma unroll
    for (int j = 0; j < 4; ++j) { const int n = (lane >> 3) + 8 * j; const LAS float* s = scr + (16 * c) * 33 + n;
        u32x4 o; o.x = pk4_fp8(s[0 * 33], s[1 * 33], s[2 * 33], s[3 * 33]); o.y = pk4_fp8(s[4 * 33], s[5 * 33], s[6 * 33], s[7 * 33]);
        o.z = pk4_fp8(s[8 * 33], s[9 * 33], s[10 * 33], s[11 * 33]); o.w = pk4_fp8(s[12 * 33], s[13 * 33], s[14 * 33], s[15 * 33]);
        __builtin_nontemporal_store(o, (GAS u32x4*)(dst + (size_t)titem8_row(t.rm, t.n0 + n) * t.K + t.k0 + 16 * c)); }
    LDS_WAIT(); asm volatile("" ::: "memory");
}

__device__ __forceinline__ void rms_row_bf16(const float* xrow, const float* g, bf16_t* orow, int lane, float* rms_out = nullptr) {
    const GAS f32x4* xr = (const GAS f32x4*)xrow + lane; const GAS f32x4* gr = (const GAS f32x4*)g + lane;
    f32x4 v[8]; float s = 0.f;
#pragma unroll
    for (int j = 0; j < 8; ++j) { v[j] = __builtin_nontemporal_load(xr + 64 * j); s += (v[j].x * v[j].x + v[j].y * v[j].y) + (v[j].z * v[j].z + v[j].w * v[j].w); }
    const float rms = sqrtf(wave_sum(s) * (1.f / D) + EPS), rs = 1.0f / rms;
    if (rms_out && lane == 0) *rms_out = rms;
    GAS u32x2* o = (GAS u32x2*)orow + lane;
#pragma unroll
    for (int j = 0; j < 8; ++j) { const f32x4 g4 = gr[64 * j]; u32x2 w; w.x = pk2(v[j].x * rs * g4.x, v[j].y * rs * g4.y); w.y = pk2(v[j].z * rs * g4.z, v[j].w * rs * g4.w); o[64 * j] = w; }
}

__device__ __forceinline__ void p0_experts(const Args& a, LAS unsigned char* lds, int worker, int nworkers, int wave, int lane) {
    unsigned char* ws = a.ws;
    LAS float* scr = (LAS float*)(lds + wave * 20352);
    constexpr int I_E8 = 512, I_G8 = NE * I_E8, NITEMS8 = 3 * I_G8;
    unsigned char* WGU = ws + WS_WGU; unsigned char* WD = ws + WS_WD;
    auto decode8 = [&](int it, TItem& t) {
        int r = it, nblk;
        if (r < I_G8) { const int e = r / I_E8; r %= I_E8; t.src = a.in[I_WGATE] + (size_t)e * D * DE; t.dst = (bf16_t*)(WGU + (size_t)e * 2048 * D); t.K = D; t.N = DE; t.rm = 4; nblk = DE / 32; }
        else if ((r -= I_G8) < I_G8) { const int e = r / I_E8; r %= I_E8; t.src = a.in[I_WUP] + (size_t)e * D * DE; t.dst = (bf16_t*)(WGU + (size_t)e * 2048 * D); t.K = D; t.N = DE; t.rm = 5; nblk = DE / 32; }
        else { r -= I_G8; const int e = r / I_E8; r %= I_E8; t.src = a.in[I_WDOWN] + (size_t)e * DE * D; t.dst = (bf16_t*)(WD + (size_t)e * D * DE); t.K = DE; t.N = D; t.rm = 0; nblk = D / 32; }
        t.k0 = 128 * (r / nblk); t.n0 = 32 * (r % nblk);
    };
    if (worker < NITEMS8) {
        TItem ta, tb; f32x4 va[16], vb[16];
        decode8(worker, ta); titem8_load(ta, lane, va);
        for (int it = worker; it < NITEMS8; it += 2 * nworkers) {
            const int i1 = it + nworkers < NITEMS8 ? it + nworkers : it, i2 = it + 2 * nworkers < NITEMS8 ? it + 2 * nworkers : it;
            decode8(i1, tb); titem8_load(tb, lane, vb);
            titem8_store(ta, lane, va, scr);
            decode8(i2, ta); titem8_load(ta, lane, va);
            titem8_store(tb, lane, vb, scr);
        }
    }
}
template <int PART>
__device__ __forceinline__ void p0_prologue(const Args& a, LAS unsigned char* lds, int gw, int NGW, int wave, int lane) {
    unsigned char* ws = a.ws;
    LAS float* scr = (LAS float*)(lds + wave * 20352);
    constexpr int I_IN = 32 * 160, I_OUT = 32 * 64, IT_LO = (PART & 1) ? 0 : I_IN, NITEMS = (PART & 2) ? I_IN + I_OUT : I_IN;
    bf16_t* WIN = (bf16_t*)(ws + WS_WIN); bf16_t* WOUT = (bf16_t*)(ws + WS_WOUT);
    auto decode = [&](int it, TItem& t) {
        int r = it, nblk;
        if (r < I_IN) { t.src = a.in[I_WIN]; t.dst = WIN; t.K = D; t.N = DIN; t.rm = 1; nblk = DIN / 32; }
        else { r -= I_IN; t.src = a.in[I_WOUT]; t.dst = WOUT; t.K = D; t.N = D; t.rm = 0; nblk = D / 32; }
        t.k0 = 64 * (r / nblk); t.n0 = 32 * (r % nblk);
    };
    if (IT_LO + gw < NITEMS) {
        TItem cur, nxt; f32x4 v[8], vn[8];
        decode(IT_LO + gw, cur); titem_load(cur, lane, v);
        for (int it = IT_LO + gw; it < NITEMS; it += NGW) {
            const int nit = it + NGW < NITEMS ? it + NGW : it;
            decode(nit, nxt); titem_load(nxt, lane, vn);
            titem_store(cur, lane, v, scr);
            cur = nxt;
#pragma unroll
            for (int i = 0; i < 8; ++i) v[i] = vn[i];
        }
    }
    bf16_t* XN = (bf16_t*)(ws + WS_XN); bf16_t* XNM = (bf16_t*)(ws + WS_SMALL + SM_XNM);
    if (PART & 1) for (int m = gw; m < M + NMETA; m += NGW) {
        if (m < M) rms_row_bf16(a.in[I_X] + (size_t)m * D, a.in[I_GMIX], XN + (size_t)m * D, lane, (float*)(ws + WS_SMALL + SM_XRMS) + m);
        else rms_row_bf16(a.in[I_META] + (size_t)(m - M) * D, a.in[I_GMIX], XNM + (size_t)(m - M) * D, lane);
    }
    if (!(PART & 2)) return;
    const int gt = gw * 64 + lane, NT = NGW * 64;
    bf16_t* WH = (bf16_t*)(ws + WS_SMALL + SM_WG36); bf16_t* WL = WH + 48 * D;
    for (int i = gt; i < D * 48; i += NT) { const int j = i / D, d = i % D; float w = 0.f; if (j < 4) w = a.in[I_WGRP][d * 4 + j]; else if (j < 36) w = a.in[I_WRT][d * 32 + (j - 4)]; w *= a.in[I_GFFN][d];
        const unsigned hb = f2bf(w); const float hf = __builtin_bit_cast(float, hb << 16); WH[i] = (bf16_t)hb; WL[i] = (bf16_t)f2bf(w - hf); }
    { float* GI = (float*)(ws + WS_SMALL + SM_GINV); for (int i = gt; i < D; i += NT) GI[i] = 1.0f / a.in[I_GMIX][i]; }
    float* BT = (float*)(ws + WS_SMALL + SM_BIAS);
    for (int i = gt; i < NH * 132; i += NT) { const int h = i / 132, idx = i % 132; float v;
        if (idx == 0) v = -INFINITY; else if (idx >= 129) v = 0.f;
        else { const int n = idx - 1; int bucket; if (n < 16) bucket = n; else { int lg = 16 + (int)(logf((float)n / 16.f) / 2.0794415416798357f * 16.f); bucket = lg < 31 ? lg : 31; }
            v = (a.in[I_RELB][bucket * NH + h] - a.in[I_RELB][31 * NH + h]) * LOG2E; }
        BT[i] = v; }
    for (int i = gt; i < 3 * NB * 48 * 128; i += NT) { const int t = 1 + i / (NB * 48 * 128), r = i % (NB * 48 * 128), b = r / (48 * 128), q = r % (48 * 128);
        *(GAS u32x4*)(ws + WS_PROJ + (size_t)t * PROJ_TSTRIDE + ((size_t)b * TP * 1024 + (size_t)q * 8) * 2) = (u32x4){0u, 0u, 0u, 0u}; }
}

__device__ __forceinline__ void p1_meta(const Args& a, LAS unsigned char* lds, int vcu, int G, int wave, int lane) {
    unsigned char* ws = a.ws;
    const bf16_t* XNM = (const bf16_t*)(ws + WS_SMALL + SM_XNM); const bf16_t* WIN = (const bf16_t*)(ws + WS_WIN);
    LAS f32x4* PS = (LAS f32x4*)lds;
    for (int task = vcu; task < 192; task += G) {
        const int n0 = 1024 + task * 16, r = lane & 15, kq = lane >> 4;
        const GAS bf16x8* ap = (const GAS bf16x8*)(XNM + (size_t)r * D + wave * 256 + kq * 8); const GAS bf16x8* bp = (const GAS bf16x8*)(WIN + (size_t)(n0 + r) * D + wave * 256 + kq * 8);
        f32x4 acc = (f32x4){0.f, 0.f, 0.f, 0.f};
#pragma unroll
        for (int kk = 0; kk < 8; ++kk) acc = __builtin_amdgcn_mfma_f32_16x16x32_bf16(ap[kk * 4], bp[kk * 4], acc, 0, 0, 0);
        PS[wave * 64 + lane] = acc;
        __syncthreads();
        if (wave == 0) {
#pragma unroll
            for (int w = 1; w < 8; ++w) acc += PS[w * 64 + lane];
            const int t = n0 >> 10, col = (n0 & 1023) + r;
            bf16_t* T = (bf16_t*)(ws + WS_PROJ + (size_t)t * PROJ_TSTRIDE);
#pragma unroll
            for (int b = 0; b < NB; ++b)
#pragma unroll
                for (int i = 0; i < 4; ++i) T[((size_t)b * TP + 48 + 4 * kq + i) * 1024 + col] = (bf16_t)f2bf(acc[i]);
        }
        __syncthreads();
    }
}

struct EpiProj {
    static constexpr bool PERM = true, SIGNALS = false;
    unsigned char* base;
    __device__ __forceinline__ void prefetch(const pg8::Unit&, int, int, float (&)[8]) const {}
    __device__ __forceinline__ void operator()(const f32x4 (&acc)[2][2][4][2], const pg8::Unit& u, int wr, int wc, int fr_, int fq_, const float (&pre)[8]) const {
        int fr = fr_, fq = fq_; asm volatile("" : "+v"(fr), "+v"(fq));
        const int b = u.pm >> 5; const int row0 = u.pm * 256 + wr * 64 + fr + TPAD * (b + 1);
        const int t = u.pn >> 2; const float sc = (t == 0) ? C2 : 1.f;
        bf16_t* T = (bf16_t*)(base + (size_t)t * PROJ_TSTRIDE);
        const int col0 = (u.pn & 3) * 256 + wc * 32 + 8 * fq;
#pragma unroll
        for (int ai = 0; ai < 2; ++ai)
#pragma unroll
            for (int m = 0; m < 4; ++m) { bf16_t* rowp = T + (size_t)(row0 + ai * 128 + m * 16) * 1024 + col0;
#pragma unroll
                for (int bj = 0; bj < 2; ++bj) { const f32x4 v0 = acc[ai][bj][m][0] * sc, v1 = acc[ai][bj][m][1] * sc;
                    u32x4 w; w.x = cvt_pk_bf16(v0[0], v0[1]); w.y = cvt_pk_bf16(v0[2], v0[3]); w.z = cvt_pk_bf16(v1[0], v1[1]); w.w = cvt_pk_bf16(v1[2], v1[3]);
                    *(u32x4*)(rowp + bj * 128) = w; } }
    }
};
}
namespace attn2 {
using bf16=__hip_bfloat16;
using s16x4=__attribute__((ext_vector_type(4)))short;
using mk::bf16x8; using mk::f32x16; using mk::u32x4;
constexpr int D=64,DM=1024,OP=1024;
constexpr int NW=8,QBLK=32,QB=QBLK*NW,KVBLK=64;
__device__ __forceinline__ int crow(int r,int hi){return (r&3)+8*(r>>2)+4*hi;}
#define SBAR() __builtin_amdgcn_sched_barrier(0)
typedef __attribute__((address_space(3))) const float* lds_fptr;
template<bool FIRST> __device__ __forceinline__ void biasmask(f32x16&p0,f32x16&p1,int t,int rq,int hi,lds_fptr tab){
  int hi2=hi; asm volatile("":"+v"(hi2)); const int kb=64*t+4*hi2;
  #pragma unroll
  for(int r=0;r<16;++r){const int kv=kb+(r&3)+8*(r>>2); const int rel=rq-kv;
    int i0=rel<-1?-1:rel; i0=i0>128?128:i0; int i1=rel-32<-1?-1:rel-32; i1=i1>128?128:i1;
    p0[r]+=tab[i0+1]; p1[r]+=tab[i1+1];
    if(FIRST){p0[r]=-INFINITY; if(kv+32<48)p1[r]=-INFINITY;}}
}

constexpr int NSLOT=4, SLOTB=8192;
constexpr int LDS_K=0, LDS_V=NSLOT*SLOTB, LDS_WS=3*NSLOT*SLOTB, LDS_OST=LDS_WS+NW*64*4, LDS_TAB=LDS_OST+NW*4096, LDS_BYTES=LDS_TAB+8*132*4;
__device__ __forceinline__ void glds16(const void*gsrc,unsigned lds_dst){unsigned keep;
  asm volatile("s_mov_b32 %0, m0\n\ts_mov_b32 m0, %2\n\ts_nop 0\n\tglobal_load_lds_dwordx4 %1, off\n\ts_mov_b32 m0, %0":"=&s"(keep):"v"(gsrc),"s"(lds_dst):"memory");}
__device__ __forceinline__ float max3f(float a,float b,float c){float r;asm("v_max3_f32 %0, %1, %2, %3":"=v"(r):"v"(a),"v"(b),"v"(c));return r;}
__device__ __forceinline__ float max2f(float a,float b){float r;asm("v_max_f32_e32 %0, %1, %2":"=v"(r):"v"(a),"v"(b));return r;}
__device__ __forceinline__ float fadd_s(float a,float b){float r;asm("v_add_f32_e32 %0, %1, %2":"=v"(r):"v"(a),"v"(b));return r;}
__device__ __forceinline__ float fsub_s(float a,float b){float r;asm("v_sub_f32_e32 %0, %1, %2":"=v"(r):"v"(a),"v"(b));return r;}
typedef float f32x2_t __attribute__((ext_vector_type(2))); typedef __bf16 bf16x2_t __attribute__((ext_vector_type(2)));
__device__ __forceinline__ unsigned cvtpk_s(float lo,float hi){f32x2_t v={lo,hi};bf16x2_t b=__builtin_convertvector(v,bf16x2_t);return __builtin_bit_cast(unsigned,b);}
#define WAIT_BAR(N) asm volatile("s_waitcnt vmcnt(" #N ") lgkmcnt(0)\n\ts_barrier":::"memory")

__device__ __forceinline__ void qkt(f32x16&p0,f32x16&p1,const char*Kslot,const bf16x8*qr,const f32x16&negm,int r32,int hi){
  const char*kb=Kslot+hi*1024+r32*16;
  #pragma unroll
  for(int d0=0;d0<4;++d0){
    const bf16x8 b0=*reinterpret_cast<const bf16x8*>(kb+d0*2048);
    const bf16x8 b1=*reinterpret_cast<const bf16x8*>(kb+d0*2048+512);
    if(d0==0){p0=__builtin_amdgcn_mfma_f32_32x32x16_bf16(b0,qr[0],negm,0,0,0);p1=__builtin_amdgcn_mfma_f32_32x32x16_bf16(b1,qr[0],negm,0,0,0);}
    else{p0=__builtin_amdgcn_mfma_f32_32x32x16_bf16(b0,qr[d0],p0,0,0,0);p1=__builtin_amdgcn_mfma_f32_32x32x16_bf16(b1,qr[d0],p1,0,0,0);}}
}
typedef __attribute__((address_space(3))) const char* lds_cptr;
typedef short v4i16_t __attribute__((ext_vector_type(4)));
__device__ __forceinline__ void kload8(bf16x8*kf,lds_cptr kp){
  kf[0]=*(const __attribute__((address_space(3))) bf16x8*)(kp);      kf[1]=*(const __attribute__((address_space(3))) bf16x8*)(kp+512);
  kf[2]=*(const __attribute__((address_space(3))) bf16x8*)(kp+2048); kf[3]=*(const __attribute__((address_space(3))) bf16x8*)(kp+2560);
  kf[4]=*(const __attribute__((address_space(3))) bf16x8*)(kp+4096); kf[5]=*(const __attribute__((address_space(3))) bf16x8*)(kp+4608);
  kf[6]=*(const __attribute__((address_space(3))) bf16x8*)(kp+6144); kf[7]=*(const __attribute__((address_space(3))) bf16x8*)(kp+6656);
}
__device__ __forceinline__ void kload2(bf16x8*kf,lds_cptr kp,int j){ kf[2*j]=*(const __attribute__((address_space(3))) bf16x8*)(kp+j*2048); kf[2*j+1]=*(const __attribute__((address_space(3))) bf16x8*)(kp+j*2048+512); }
__device__ __forceinline__ s16x4 vtr(lds_cptr p){ return __builtin_bit_cast(s16x4,__builtin_amdgcn_ds_read_tr16_b64_v4i16((__attribute__((address_space(3))) v4i16_t*)p)); }
__device__ __forceinline__ float rowmax(const f32x16&p0,const f32x16&p1){
  float a=max3f(p0[0],p0[1],p1[0]),b=max3f(p0[2],p0[3],p1[1]);a=max3f(a,p1[2],p1[3]);
  #pragma unroll
  for(int r=4;r<16;r+=4){a=max3f(a,p0[r],p0[r+1]);b=max3f(b,p0[r+2],p0[r+3]);a=max3f(a,p1[r],p1[r+1]);b=max3f(b,p1[r+2],p1[r+3]);}
  const float m=max2f(a,b);
  auto rr=__builtin_amdgcn_permlane32_swap(__float_as_uint(m),__float_as_uint(m),false,false);
  return max2f(__uint_as_float(rr[0]),__uint_as_float(rr[1]));
}
__device__ __forceinline__ void pv(f32x16*o,int vb,bf16x8 pa0,bf16x8 pa1,bf16x8 pa2,bf16x8 pa3){
  #pragma unroll
  for(int d0=0;d0<4;++d0){s16x4 lo[4],hi[4];
    #pragma unroll
    for(int ks=0;ks<4;++ks){
      asm volatile("ds_read_b64_tr_b16 %0,%1 offset:%c2":"=&v"(lo[ks]):"v"(vb),"i"(d0*4096+ks*1024):"memory");
      asm volatile("ds_read_b64_tr_b16 %0,%1 offset:%c2":"=&v"(hi[ks]):"v"(vb),"i"(d0*4096+ks*1024+512):"memory");}
    asm volatile("s_waitcnt lgkmcnt(0)":::"memory");SBAR();
    #define PK(k) (bf16x8){lo[k][0],lo[k][1],lo[k][2],lo[k][3],hi[k][0],hi[k][1],hi[k][2],hi[k][3]}
    o[d0]=__builtin_amdgcn_mfma_f32_32x32x16_bf16(pa0,PK(0),o[d0],0,0,0);
    o[d0]=__builtin_amdgcn_mfma_f32_32x32x16_bf16(pa1,PK(1),o[d0],0,0,0);
    o[d0]=__builtin_amdgcn_mfma_f32_32x32x16_bf16(pa2,PK(2),o[d0],0,0,0);
    o[d0]=__builtin_amdgcn_mfma_f32_32x32x16_bf16(pa3,PK(3),o[d0],0,0,0);
    #undef PK
  }
}

#ifndef ATTN_STORE16
#define ATTN_STORE16(p,v) (*(u32x4*)(p)=(v))
#endif
template<int THRL> __device__ __forceinline__ void attn_unit(int b,int hq,int hvc,int hoc,int qb,const bf16*Q,const bf16*__restrict__ K,const bf16*__restrict__ V,bf16*O,char*shm,bool comb,bf16*MIXO,float lam,const float*sg){
  const int tid=threadIdx.x,lane=tid&63,r32=lane&31,hi=lane>>5; const int wid=__builtin_amdgcn_readfirstlane(tid>>6);
  const long rowbase=(long)b*mk::TP; const int q0=mk::TPAD+qb*QB;
  const bf16*Qw=Q+(rowbase+q0+wid*QBLK)*DM+hq*D;
  const bf16*Kh=K+rowbase*DM+hq*D,*Vh=V+rowbase*DM+hvc;
  const unsigned lds0=(unsigned)(uintptr_t)shm;
  float*wsf=(float*)(shm+LDS_WS)+wid*64;
  const bf16*ksrc=Kh+(long)lane*DM+wid*8;
  const bf16*vsrc=Vh+(long)(16*(wid&3)+(lane>>2))*DM+(wid>>2)*32+(lane&3)*8;
  const unsigned kdst=lds0+LDS_K+wid*1024, vdst=lds0+LDS_V+wid*1024;
  const __amdgpu_buffer_rsrc_t rK=__builtin_amdgcn_make_buffer_rsrc((void*)K,0,0x7fffffff,0x00020000), rV=__builtin_amdgcn_make_buffer_rsrc((void*)V,0,0x7fffffff,0x00020000);
  const int kvo=(int)(((long)lane*DM+wid*8)*2), vvo=(int)(((long)(16*(wid&3)+(lane>>2))*DM+(wid>>2)*32+(lane&3)*8)*2);
  const int kso=(int)((rowbase*DM+hq*D)*2), vso=(int)((rowbase*DM+hvc)*2);
  typedef __attribute__((address_space(3))) void* lds_vptr; const __attribute__((address_space(3))) char* shl=(const __attribute__((address_space(3))) char*)shm;
  #define DMA_K(t,slot) __builtin_amdgcn_raw_ptr_buffer_load_lds(rK,(lds_vptr)(shl+LDS_K+wid*1024+(slot)),16,kvo,kso+(t)*(KVBLK*DM*2),0,0)
  #define DMA_V(t,slot) do{ __builtin_amdgcn_raw_ptr_buffer_load_lds(rV,(lds_vptr)(shl+LDS_V+wid*1024+2*(slot)),16,vvo,vso+(t)*(KVBLK*DM*2),0,0); __builtin_amdgcn_raw_ptr_buffer_load_lds(rV,(lds_vptr)(shl+LDS_V+wid*1024+2*(slot)+8192),16,vvo,vso+(t)*(KVBLK*DM*2)+128,0,0); }while(0)
  const int vb0=(int)(lds0+LDS_V)+((lane>>4)&1)*32+(lane&3)*8+(4*hi+((lane&15)>>2))*64;
  const char*Kbase=shm+LDS_K; bf16x8 kf[8];
  const lds_cptr shm3=(lds_cptr)shm; const lds_cptr kp0=shm3+LDS_K+hi*1024+r32*16; const lds_cptr vp0=shm3+LDS_V+((lane>>4)&1)*32+(lane&3)*8+(4*hi+((lane&15)>>2))*64;
  const int NT=(q0+QB)/KVBLK;
  const lds_fptr tabl=(lds_fptr)((__attribute__((address_space(3))) const char*)shm+LDS_TAB)+(hq>>1)*132;
  DMA_K(0,0);DMA_V(0,0);DMA_K(1,SLOTB);
  bf16x8 qr[4];
  #pragma unroll
  for(int d0=0;d0<4;++d0)qr[d0]=*reinterpret_cast<const bf16x8*>(&Qw[(long)r32*DM+d0*16+hi*8]);
  #define QF(d0) qr[d0]
  float mhat=0.f,l_reg=0.f;f32x16 o[4];o[0]=f32x16{};o[1]=f32x16{};o[2]=f32x16{};o[3]=f32x16{};const f32x16 zero16=f32x16{};
  typedef short s16x4_ __attribute__((ext_vector_type(4)));
  s16x4_ kx=(s16x4_){(short)(hi==0?0x3F80:0),0,0,0}, qx=(s16x4_){0,0,0,0};
  #define BFR(x) __builtin_bit_cast(float,(mk::f2bf(x))<<16)
  #define SETQX() do{ qx[0]=(short)(hi==0?(mk::f2bf(-mhat)):0u); asm volatile("":"+v"(qx)); }while(0)
  #define MFX() __builtin_amdgcn_mfma_f32_32x32x8bf16_1k(kx,qx,zero16,0,0,0)
  const int rq=q0+wid*QBLK+r32;
  #define CMASK(P0,P1,t) biasmask<true>(P0,P1,0,rq,hi,tabl)
  bool resc=false;
  #define START(P0,P1) do{ const float rm=rowmax(P0,P1); resc=false; mhat=BFR(rm); SETQX(); \
    _Pragma("unroll") for(int r=0;r<16;++r)P0[r]=__builtin_amdgcn_exp2f(fsub_s(P0[r],mhat)); }while(0)
  #define RESC() do{ if(resc){ asm volatile("s_waitcnt lgkmcnt(0)":::"memory"); \
      _Pragma("unroll") for(int d_=0;d_<4;++d_) _Pragma("unroll") for(int r=0;r<16;++r)o[d_][r]*=wsf[crow(r,hi)]; } }while(0)
  f32x16 pA0,pA1,pB0,pB1;
  int sl_prev=0,sl_cur=0,sl_next=SLOTB;
  #define ROT() do{sl_prev=sl_cur;sl_cur=sl_next;sl_next=(sl_next==(NSLOT-1)*SLOTB)?0:sl_next+SLOTB;}while(0)
  DMA_K(2,2*SLOTB);
  WAIT_BAR(4);
  qkt(pA0,pA1,Kbase,qr,zero16,r32,hi);asm volatile("s_nop 15\n\ts_nop 7":"+v"(pA0),"+v"(pA1));CMASK(pA0,pA1,0);
  START(pA0,pA1);
  _Pragma("unroll") for(int r=0;r<16;++r)pA1[r]=__builtin_amdgcn_exp2f(fsub_s(pA1[r],mhat));
  WAIT_BAR(0);
  DMA_K(3,3*SLOTB);DMA_V(1,SLOTB);
  ROT();
  kload8(kf,kp0+sl_cur);
  WAIT_BAR(3);
  s16x4 vlo[16],vhi[16]; u32x4 pw0,pw1,pw2,pw3;
  #define PKW(P,B) cvtpk_s(P[B],P[B+1])
  #define PAF(k) __builtin_bit_cast(bf16x8,pw##k)
  #define VFR(i) (bf16x8){vlo[i][0],vlo[i][1],vlo[i][2],vlo[i][3],vhi[i][0],vhi[i][1],vhi[i][2],vhi[i][3]}
  #define PIN(x) asm volatile("":"+v"(x))
  #define MX3(a,b,c) __builtin_fmaxf(__builtin_fmaxf((a),(b)),(c))
  #define GAPA(MF,A0,A1,A2,A3,W0,W1,PW) do{ MF; sacc+=A0; sacb+=A1; sacc+=A2; sacb+=A3; PIN(sacc); PIN(sacb); W0; W1; PIN(PW); SBAR(); }while(0)
  #define EX(v) __builtin_amdgcn_exp2f(v)
  #define GAPB(MF,X,B) do{ MF; X[B]=EX(X[B]); X[B+1]=EX(X[B+1]); PIN(X); SBAR(); }while(0)
  #define VRD(i) do{ vlo[i]=vtr(vp_+(((i)>>2)*4096+((i)&3)*1024)); vhi[i]=vtr(vp_+(((i)>>2)*4096+((i)&3)*1024+512)); }while(0)
  #define KRD(G,j) do{ if(G){ kload2(kf,kp0+sl_next,j); SBAR(); } }while(0)
  #define MFM(a_,b_,c_) __builtin_amdgcn_mfma_f32_32x32x16_bf16(a_,b_,c_,0,0,0)
  #define HALFA(C0,C1,P0,P1,t,GK,GV,DM) do{ SBAR(); \
    const lds_cptr vp_=vp0+2*sl_prev; \
    VRD(0); qb_=QF(1); SBAR(); float sacc=P0[0], sacb=P0[1]; \
    GAPA(C0=MFM(kf[0],qa_,MFX()), P0[2],P0[3],P0[4],P0[5],     pw0[0]=PKW(P0,0), pw0[1]=PKW(P0,2), pw0); \
    VRD(4); SBAR(); GAPA(C1=MFM(kf[1],qa_,MFX()), P0[6],P0[7],P0[8],P0[9],     pw0[2]=PKW(P0,4), pw0[3]=PKW(P0,6), pw0); \
    VRD(8); qa_=QF(2); SBAR(); GAPA(C0=MFM(kf[2],qb_,C0),   P0[10],P0[11],P0[12],P0[13], pw1[0]=PKW(P0,8), pw1[1]=PKW(P0,10), pw1); \
    VRD(12);SBAR(); GAPA(C1=MFM(kf[3],qb_,C1),   P0[14],P0[15],P1[0],P1[1],   pw1[2]=PKW(P0,12),pw1[3]=PKW(P0,14), pw1); \
    VRD(1); qb_=QF(3); SBAR(); GAPA(C0=MFM(kf[4],qa_,C0),   P1[2],P1[3],P1[4],P1[5],     pw2[0]=PKW(P1,0), pw2[1]=PKW(P1,2), pw2); \
    VRD(5); SBAR(); GAPA(C1=MFM(kf[5],qa_,C1),   P1[6],P1[7],P1[8],P1[9],     pw2[2]=PKW(P1,4), pw2[3]=PKW(P1,6), pw2); \
    VRD(9); qa_=QF(0); SBAR(); GAPA(C0=MFM(kf[6],qb_,C0),   P1[10],P1[11],P1[12],P1[13], pw3[0]=PKW(P1,8), pw3[1]=PKW(P1,10), pw3); \
    VRD(13);SBAR(); GAPA(C1=MFM(kf[7],qb_,C1),   P1[14],P1[15],0.f,0.f,       pw3[2]=PKW(P1,12),pw3[3]=PKW(P1,14), pw3); \
    l_reg+=sacc+sacb; \
    if(DM){ if(GK){DMA_K((t)+3,sl_prev);} if(GV){DMA_V((t)+1,sl_next);} } \
    CMASK(C0,C1,t); \
    { float a=MX3(C0[0],C0[1],C1[0]),b=MX3(C0[2],C0[3],C1[1]); a=MX3(a,C1[2],C1[3]); \
      _Pragma("unroll") for(int r=4;r<16;r+=4){a=MX3(a,C0[r],C0[r+1]);b=MX3(b,C0[r+2],C0[r+3]);a=MX3(a,C1[r],C1[r+1]);b=MX3(b,C1[r+2],C1[r+3]);} \
      float rm=__builtin_fmaxf(a,b); { auto rr=__builtin_amdgcn_permlane32_swap(__float_as_uint(rm),__float_as_uint(rm),false,false); rm=__builtin_fmaxf(__uint_as_float(rr[0]),__uint_as_float(rr[1])); } \
      resc=false; const float dm=rm;                   \
      if(__builtin_expect(__any(dm>(float)THRL),0)){ const float mn=BFR(mhat+__builtin_fmaxf(dm,0.f)); const float dl=mn-mhat; mhat=mn; SETQX(); \
        _Pragma("unroll") for(int r=0;r<16;++r){ C0[r]-=dl; C1[r]-=dl; }          \
        const float f=__builtin_amdgcn_exp2f(-dl); l_reg*=f; if(hi==0)wsf[r32]=f; resc=true; } } \
    SBAR(); \
    }while(0)
  #define HALFB(C0,C1,P0,P1,t,GK,GV,GL,DM) do{ \
    const lds_cptr vp_=vp0+2*sl_prev; \
    if(DM){ if(GK){DMA_K((t)+3,sl_prev);} if(GV){DMA_V((t)+1,sl_next);} } \
      \
    VRD(2); SBAR(); GAPB(o[0]=MFM(PAF(0),VFR(0),o[0]),  C0,0); \
    VRD(6); SBAR(); GAPB(o[1]=MFM(PAF(0),VFR(4),o[1]),  C0,2); \
    VRD(10);SBAR(); GAPB(o[2]=MFM(PAF(0),VFR(8),o[2]),  C0,4); \
    VRD(14);SBAR(); GAPB(o[3]=MFM(PAF(0),VFR(12),o[3]), C0,6); \
    VRD(3); SBAR(); GAPB(o[0]=MFM(PAF(1),VFR(1),o[0]),  C0,8); \
    VRD(7); SBAR(); GAPB(o[1]=MFM(PAF(1),VFR(5),o[1]),  C0,10); \
    VRD(11);SBAR(); GAPB(o[2]=MFM(PAF(1),VFR(9),o[2]),  C0,12); \
    VRD(15);SBAR(); GAPB(o[3]=MFM(PAF(1),VFR(13),o[3]), C0,14); \
    KRD(GL,0); GAPB(o[0]=MFM(PAF(2),VFR(2),o[0]),  C1,0); \
    KRD(GL,1); GAPB(o[1]=MFM(PAF(2),VFR(6),o[1]),  C1,2); \
    KRD(GL,2); GAPB(o[2]=MFM(PAF(2),VFR(10),o[2]), C1,4); \
    KRD(GL,3); GAPB(o[3]=MFM(PAF(2),VFR(14),o[3]), C1,6); \
    GAPB(o[0]=MFM(PAF(3),VFR(3),o[0]),  C1,8); \
    GAPB(o[1]=MFM(PAF(3),VFR(7),o[1]),  C1,10); \
    GAPB(o[2]=MFM(PAF(3),VFR(11),o[2]), C1,12); \
    GAPB(o[3]=MFM(PAF(3),VFR(15),o[3]), C1,14); \
    }while(0)
  #define STEP(C0,C1,P0,P1,t,GK,GV,GL) do{ HALFA(C0,C1,P0,P1,t,GK,GV,true); HALFB(C0,C1,P0,P1,t,GK,GV,GL,false); }while(0)
  bf16x8 qa_=QF(0),qb_;
  int t=1;
  #undef CMASK
  #define CMASK(P0,P1,t) do{}while(0)
  const bool lag=wid>=4;
  for(;t+8<=NT;t+=2){
      HALFA(pB0,pB1,pA0,pA1,t,true,true,true);        if(lag){ WAIT_BAR(3); }
      HALFB(pB0,pB1,pA0,pA1,t,true,true,true,false);  if(!lag){ WAIT_BAR(3); } RESC(); ROT();
      HALFA(pA0,pA1,pB0,pB1,t+1,true,true,true);      if(lag){ WAIT_BAR(3); }
      HALFB(pA0,pA1,pB0,pB1,t+1,true,true,true,false);if(!lag){ WAIT_BAR(3); } RESC(); ROT();
  }
  #undef CMASK
  #define CMASK(P0,P1,t) biasmask<false>(P0,P1,(t),rq,hi,tabl)
  #define ENDW(tt) do{ if((tt)+3<NT){WAIT_BAR(3);} else if((tt)+2<NT){WAIT_BAR(2);} else {WAIT_BAR(0);} }while(0)
  for(;t+2<NT;t+=2){
    STEP(pB0,pB1,pA0,pA1,t,(t+3<NT),(t+1<NT),(t+1<NT));       ENDW(t);   RESC(); ROT();
    STEP(pA0,pA1,pB0,pB1,t+1,(t+4<NT),(t+2<NT),(t+2<NT));     ENDW(t+1); RESC(); ROT();
  }
  STEP(pB0,pB1,pA0,pA1,t,false,true,true);      WAIT_BAR(0); RESC(); ROT();
  STEP(pA0,pA1,pB0,pB1,t+1,false,false,false);  RESC();
  { float sacc=pA0[0]+pA0[1]; _Pragma("unroll") for(int r=2;r<16;++r)sacc+=pA0[r]; _Pragma("unroll") for(int r=0;r<16;++r)sacc+=pA1[r]; l_reg+=sacc;
    pw0=(u32x4){PKW(pA0,0),PKW(pA0,2),PKW(pA0,4),PKW(pA0,6)};pw1=(u32x4){PKW(pA0,8),PKW(pA0,10),PKW(pA0,12),PKW(pA0,14)};pw2=(u32x4){PKW(pA1,0),PKW(pA1,2),PKW(pA1,4),PKW(pA1,6)};pw3=(u32x4){PKW(pA1,8),PKW(pA1,10),PKW(pA1,12),PKW(pA1,14)};
    SBAR(); pv(o,vb0+2*sl_cur,PAF(0),PAF(1),PAF(2),PAF(3)); }
  #undef PKW
  #undef PAF
  #undef VFR
  #undef PIN
  #undef MX3
  #undef GAPA
  #undef GAPB
  #undef EX
  #undef VRD
  #undef KRD
  #undef STEP
  #undef HALFA
  #undef HALFB
  #undef MFM
  #undef QF
  #undef ENDW
  {auto rr=__builtin_amdgcn_permlane32_swap(__float_as_uint(l_reg),__float_as_uint(l_reg),false,false);l_reg=__uint_as_float(rr[0])+__uint_as_float(rr[1]);}
  if(hi==0)wsf[32+r32]=l_reg;asm volatile("s_waitcnt lgkmcnt(0)":::"memory");
  float rli[16];
  #pragma unroll
  for(int r=0;r<16;++r)rli[r]=__builtin_amdgcn_rcpf(wsf[32+crow(r,hi)]);
  bf16*Ow=O+((long)b*mk::SEQ+qb*QB+wid*QBLK)*OP+hoc;
  int lane_e=lane; asm volatile("":"+v"(lane_e));
  const int r32e=lane_e&31, hie=lane_e>>5;
  { bf16*stg=(bf16*)(shm+LDS_OST)+wid*2048;
    float oh[2][4][8]; float ssr[4]={0.f,0.f,0.f,0.f};
    #pragma unroll
    for(int hh=0;hh<2;++hh){
      #pragma unroll
      for(int r=0;r<16;++r){const int orow=crow(r,hie);
        #pragma unroll
        for(int d0=0;d0<2;++d0)stg[orow*64+d0*32+r32e]=__float2bfloat16(o[2*hh+d0][r]*rli[r]);}
      asm volatile("s_waitcnt lgkmcnt(0)":::"memory");
      #pragma unroll
      for(int i=0;i<4;++i){const int row=i*8+(lane_e>>3),ch=lane_e&7; const u32x4 v=*(const u32x4*)(stg+row*64+ch*8);
        if(!comb){ ATTN_STORE16(Ow+(long)row*OP+hh*64+ch*8,v); }
        else{ const u32x4 z=*(const u32x4*)(Ow+(long)row*OP+hh*64+ch*8); const unsigned zw[4]={z.x,z.y,z.z,z.w},vw[4]={v.x,v.y,v.z,v.w};
          #pragma unroll
          for(int q=0;q<4;++q){ const float a0=mk::bflo(zw[q])-lam*mk::bflo(vw[q]),a1=mk::bfhi(zw[q])-lam*mk::bfhi(vw[q]); oh[hh][i][2*q]=a0; oh[hh][i][2*q+1]=a1; ssr[i]+=a0*a0+a1*a1; } } }
      asm volatile("s_waitcnt lgkmcnt(0)":::"memory");
    }
    if(comb){ const int ch=lane_e&7; float sgl[16];
      #pragma unroll
      for(int hh=0;hh<2;++hh)
        #pragma unroll
        for(int q=0;q<8;++q)sgl[hh*8+q]=sg[hh*64+ch*8+q]*0.8f;
      bf16*Mw=MIXO+((long)b*mk::SEQ+qb*QB+wid*QBLK)*2048+hoc;
      #pragma unroll
      for(int i=0;i<4;++i){ float ss=ssr[i]; ss+=__shfl_xor(ss,1); ss+=__shfl_xor(ss,2); ss+=__shfl_xor(ss,4);
        const float rs=1.0f/sqrtf(ss*(1.f/128.f)+mk::EPS); const int row=i*8+(lane_e>>3);
        #pragma unroll
        for(int hh=0;hh<2;++hh){ u32x4 w;
          w.x=mk::pk2(oh[hh][i][0]*rs*sgl[hh*8+0],oh[hh][i][1]*rs*sgl[hh*8+1]); w.y=mk::pk2(oh[hh][i][2]*rs*sgl[hh*8+2],oh[hh][i][3]*rs*sgl[hh*8+3]);
          w.z=mk::pk2(oh[hh][i][4]*rs*sgl[hh*8+4],oh[hh][i][5]*rs*sgl[hh*8+5]); w.w=mk::pk2(oh[hh][i][6]*rs*sgl[hh*8+6],oh[hh][i][7]*rs*sgl[hh*8+7]);
          *(u32x4*)(Mw+(long)row*2048+hh*64+ch*8)=w; } } }
  }
  asm volatile("s_waitcnt lgkmcnt(0)\n\ts_barrier":::"memory");
  #undef DMA_K
  #undef DMA_V
  #undef CMASK
  #undef START
  #undef RESC
  #undef ROT
}
constexpr int ATTN_LDS_BYTES=LDS_BYTES;
__device__ __forceinline__ void attn_load_tab(const float*biastab,char*shm){ __attribute__((address_space(3))) float*tw=(__attribute__((address_space(3))) float*)((__attribute__((address_space(3))) char*)shm+LDS_TAB); for(int i=threadIdx.x;i<8*132;i+=512)tw[i]=biastab[i]; }
#undef SBAR
#undef WAIT_BAR
}
namespace mk {
__device__ __forceinline__ float sigmoid_f(float x) { return __builtin_amdgcn_rcpf(1.0f + __expf(-x)); }
__device__ __forceinline__ float gelu_tanh_f(float x) { constexpr float c1 = -1.5957691216057308f * LOG2E; const float u = __builtin_fmaf(x * x, 0.044715f * c1, c1); return x * __builtin_amdgcn_rcpf(1.0f + __builtin_amdgcn_exp2f(x * u)); }
__device__ __forceinline__ bf16x8 pack8(const float (&v)[8]) { u32x4 w; w.x = cvt_pk_bf16(v[0], v[1]); w.y = cvt_pk_bf16(v[2], v[3]); w.z = cvt_pk_bf16(v[4], v[5]); w.w = cvt_pk_bf16(v[6], v[7]); return __builtin_bit_cast(bf16x8, w); }

template <int MODE>
__device__ __forceinline__ void lru_item(const Args& a, LAS unsigned char* wl, int b, int c, int blk, int lane) {
    unsigned char* ws = a.ws;
    const bf16_t* XL = (const bf16_t*)(ws + WS_PROJ + 3 * PROJ_TSTRIDE); const bf16_t* GL = (const bf16_t*)(ws + WS_PROJ + 4 * PROJ_TSTRIDE);
    f32x2* TOT = (f32x2*)(ws + WS_SMALL + SM_LRUTOT);
    bf16_t* MIX = (bf16_t*)(ws + WS_MIX);
    const int c0 = blk * 64, ch = c0 + lane, fr = lane & 15, g = lane >> 4;
    LAS float* XC = (LAS float*)wl; LAS float* AA = XC + 16 * 68; LAS float* BX = AA + 16 * 64;
    const float* Wr = a.in[I_WR] + (size_t)blk * 4096; const float* Wi = a.in[I_WI] + (size_t)blk * 4096;
    bf16x8 wrf[4][2], wif[4][2];
#pragma unroll
    for (int nt = 0; nt < 4; ++nt)
#pragma unroll
        for (int kk = 0; kk < 2; ++kk) { float t0[8], t1[8];
#pragma unroll
            for (int j = 0; j < 8; ++j) { const int k = 32 * kk + 8 * g + j; t0[j] = -LOG2E * Wr[k * 64 + 16 * nt + fr]; t1[j] = -LOG2E * Wi[k * 64 + 16 * nt + fr]; }
            wrf[nt][kk] = pack8(t0); wif[nt][kk] = pack8(t1); }
    float br[4], bi[4], ls8[4];
#pragma unroll
    for (int nt = 0; nt < 4; ++nt) { const int cc = c0 + 16 * nt + fr; br[nt] = -LOG2E * a.in[I_BR][cc]; bi[nt] = -LOG2E * a.in[I_BI][cc];
        const float L = a.in[I_LRUL][cc]; ls8[nt] = (8.f * LOG2E) * (fminf(L, 0.f) - log1pf(expf(-fabsf(L)))); }
    const float cw0 = a.in[I_CONVW][ch], cw1 = a.in[I_CONVW][1024 + ch], cw2 = a.in[I_CONVW][2048 + ch], cw3 = a.in[I_CONVW][3072 + ch], cb = a.in[I_CONVB][ch];
    const int rb = b * TP; const int r0 = rb + (c == 0 ? 48 : 64 + LCH * c); const int nsub = (c == 0) ? 9 : 8;
    float xm3 = bf2f(XL[(size_t)(r0 - 3) * 1024 + ch]), xm2 = bf2f(XL[(size_t)(r0 - 2) * 1024 + ch]), xm1 = bf2f(XL[(size_t)(r0 - 1) * 1024 + ch]);
    float h = 0.f, acum = 1.f;
    if (MODE == 1) {
        int j = 0;
        for (; j + 8 <= c; j += 8) { f32x2 t[8];
#pragma unroll
            for (int q = 0; q < 8; ++q) t[q] = TOT[(size_t)(b * NCH + j + q) * 1024 + ch];
#pragma unroll
            for (int q = 0; q < 8; ++q) h = t[q].x * h + t[q].y; }
        for (; j < c; ++j) { const f32x2 t = TOT[(size_t)(b * NCH + j) * 1024 + ch]; h = t.x * h + t.y; }
    }
    unsigned short xn[16], gn[16];
#pragma unroll
    for (int i = 0; i < 16; ++i) { xn[i] = XL[(size_t)(r0 + i) * 1024 + ch]; if (MODE == 1) gn[i] = GL[(size_t)(r0 + i) * 1024 + ch]; }
    for (int sub = 0; sub < nsub; ++sub) {
        const int rs = r0 + 16 * sub;
        float xv[16]; float gv[16];
#pragma unroll
        for (int i = 0; i < 16; ++i) { xv[i] = bf2f(xn[i]); if (MODE == 1) gv[i] = bf2f(gn[i]); }
#pragma unroll
        for (int i = 0; i < 16; ++i) { xn[i] = XL[(size_t)(rs + 16 + i) * 1024 + ch]; if (MODE == 1) gn[i] = GL[(size_t)(rs + 16 + i) * 1024 + ch]; }
#pragma unroll
        for (int i = 0; i < 16; ++i) { const float xc = cb + cw0 * xm3 + cw1 * xm2 + cw2 * xm1 + cw3 * xv[i]; XC[i * 68 + lane] = xc; xm3 = xm2; xm2 = xm1; xm1 = xv[i]; }
        bf16x8 af[2];
#pragma unroll
        for (int kk = 0; kk < 2; ++kk) { const f32x4 p = *(const LAS f32x4*)(XC + fr * 68 + 32 * kk + 8 * g), q = *(const LAS f32x4*)(XC + fr * 68 + 32 * kk + 8 * g + 4);
            const float t[8] = {p.x, p.y, p.z, p.w, q.x, q.y, q.z, q.w}; af[kk] = pack8(t); }
        f32x4 accR[4], accI[4];
#pragma unroll
        for (int nt = 0; nt < 4; ++nt) {
            accR[nt] = __builtin_amdgcn_mfma_f32_16x16x32_bf16(af[0], wrf[nt][0], (f32x4){br[nt], br[nt], br[nt], br[nt]}, 0, 0, 0); accR[nt] = __builtin_amdgcn_mfma_f32_16x16x32_bf16(af[1], wrf[nt][1], accR[nt], 0, 0, 0);
            accI[nt] = __builtin_amdgcn_mfma_f32_16x16x32_bf16(af[0], wif[nt][0], (f32x4){bi[nt], bi[nt], bi[nt], bi[nt]}, 0, 0, 0); accI[nt] = __builtin_amdgcn_mfma_f32_16x16x32_bf16(af[1], wif[nt][1], accI[nt], 0, 0, 0); }
#pragma unroll
        for (int nt = 0; nt < 4; ++nt)
#pragma unroll
            for (int r = 0; r < 4; ++r) { const int tok = 4 * g + r, cl = 16 * nt + fr;
                const float rg = __builtin_amdgcn_rcpf(1.0f + __builtin_amdgcn_exp2f(accR[nt][r])), ig = __builtin_amdgcn_rcpf(1.0f + __builtin_amdgcn_exp2f(accI[nt][r]));
                const float av = __builtin_amdgcn_exp2f(rg * ls8[nt]);
                const float om = 1.f - av * av;
                const float bxv = __builtin_amdgcn_sqrtf(om) * ig * XC[tok * 68 + cl];
                AA[tok * 64 + cl] = av; BX[tok * 64 + cl] = bxv; }
        float hs[16];
#pragma unroll
        for (int i = 0; i < 16; ++i) { const float av = AA[i * 64 + lane], bv = BX[i * 64 + lane]; h = av * h + bv; acum *= av; hs[i] = h; }
        if (MODE == 1 && rs >= rb + 64) {
#pragma unroll
            for (int i = 0; i < 16; ++i) { const int row = rs + i;
                MIX[((size_t)b * SEQ + (row - rb - 64)) * 2048 + ch] = (bf16_t)f2bf(hs[i] * gelu_tanh_f(gv[i])); }
        }
    }
    if (MODE == 0) TOT[(size_t)(b * NCH + c) * 1024 + ch] = (f32x2){acum, h};
}

__device__ __forceinline__ void p2_attn_lru(const Args& a, LAS unsigned char* lds, unsigned char* lds_generic, int vcu, int G, int wave, int lane) {
    unsigned char* ws = a.ws;
    const int gw = vcu * 8 + wave, NGW = G * 8;
    for (int it = gw; it < NB * NCH * NLB; it += NGW) lru_item<0>(a, lds + wave * 16384, it / (NCH * NLB), (it / NLB) % NCH, it % NLB, lane);
    asm volatile("s_waitcnt vmcnt(0)" ::: "memory");
    __syncthreads();
    if (threadIdx.x == 0) { __builtin_amdgcn_fence(__ATOMIC_RELEASE, "agent"); asm volatile("s_waitcnt vmcnt(0)" ::: "memory"); (void)xb_add((unsigned*)(ws + WS_CTL) + CW_LRU1, 1u); }
    attn2::attn_load_tab((const float*)(ws + WS_SMALL + SM_BIAS), (char*)lds_generic);
    __syncthreads();
    const attn2::bf16* Q = (const attn2::bf16*)(ws + WS_PROJ); const attn2::bf16* K = (const attn2::bf16*)(ws + WS_PROJ + PROJ_TSTRIDE); const attn2::bf16* V = (const attn2::bf16*)(ws + WS_PROJ + 2 * PROJ_TSTRIDE);
    attn2::bf16* O = (attn2::bf16*)(ws + WS_OALL);
    const float lam = __expf(wave_sum(a.in[I_LQ1][lane] * a.in[I_LK1][lane])) - __expf(wave_sum(a.in[I_LQ2][lane] * a.in[I_LK2][lane])) + 0.2f;
    attn2::bf16* MIXO = (attn2::bf16*)(ws + WS_MIX) + 1024;
    const int NGRP = G / 16;
    for (int grp = vcu >> 4; grp < 16; grp += NGRP) {
        const int b = grp >> 3, h = grp & 7, s = vcu & 15;
        for (int j = 0; j < 4; ++j) { const int qb = (j < 2) ? s : 31 - s, m = j & 1;
            attn2::attn_unit<8>(b, h * 2 + m, h * 128, h * 128, qb, Q, K, V, O, (char*)lds_generic, m == 1, MIXO, lam, a.in[I_SUBLN]); }
    }
    __syncthreads();
    if (threadIdx.x == 0) { unsigned sp = 0u; while (xb_ld((unsigned*)(ws + WS_CTL) + CW_LRU1) < (unsigned)G) { __builtin_amdgcn_s_sleep(8); if (++sp > (1u << 20)) break; }
        __builtin_amdgcn_fence(__ATOMIC_ACQUIRE, "agent"); asm volatile("s_waitcnt vmcnt(0)" ::: "memory"); }
    __syncthreads();
    for (int it = gw; it < NB * NCH * NLB; it += NGW) lru_item<1>(a, lds + wave * 16384, it / (NCH * NLB), (it / NLB) % NCH, it % NLB, lane);
}

__device__ __forceinline__ void p3_combine(const Args& a, LAS unsigned char* lds, int vcu, int G, int wave, int lane) {
    unsigned char* ws = a.ws;
    const int gw = vcu * 8 + wave, NGW = G * 8;
    for (int it = gw; it < NB * NCH * NLB; it += NGW) lru_item<1>(a, lds + wave * 16384, it / (NCH * NLB), (it / NLB) % NCH, it % NLB, lane);
}
}
namespace mk {
struct EpiH {
    static constexpr bool PERM = true, SIGNALS = false;
    bf16_t* H; const bf16_t* XN; const float* XRMS; const float* GINV; unsigned char* U2; const float* GFFN;
    __device__ __forceinline__ void prefetch(const pg8::Unit&, int, int, float (&)[8]) const {}
    __device__ __forceinline__ void operator()(const f32x4 (&acc)[2][2][4][2], const pg8::Unit& u, int wr, int wc, int fr_, int fq_, const float (&pre)[8]) const {
        int fr = fr_, fq = fq_; asm volatile("" : "+v"(fr), "+v"(fq));
        const int col0 = u.pn * 256 + wc * 32 + 8 * fq, row0 = u.pm * 256 + wr * 64 + fr;
        const size_t base = (size_t)row0 * 2048 + col0;
        f32x4 gi[4];
        { const GAS f32x4* gp = (const GAS f32x4*)(GINV + col0); gi[0] = gp[0]; gi[1] = gp[1]; gi[2] = gp[32]; gi[3] = gp[33]; }
        f32x4 gf[4];
        { const GAS f32x4* gp = (const GAS f32x4*)(GFFN + col0); gf[0] = gp[0]; gf[1] = gp[1]; gf[2] = gp[32]; gf[3] = gp[33]; }
        auto ld = [&](int c, u32x4 (&x)[2], float& rr) { const int ro = (c >> 2) * 128 + (c & 3) * 16; const GAS u32x4* p = (const GAS u32x4*)(XN + base + (size_t)ro * 2048);
            x[0] = __builtin_nontemporal_load(p); x[1] = __builtin_nontemporal_load(p + 16); rr = XRMS[row0 + ro]; };
        auto fin = [&](int c, const u32x4 (&x)[2], float rr) { const int ai = c >> 2, m = c & 3; bf16_t* rowp = H + base + (size_t)(ai * 128 + m * 16) * 2048;
#pragma unroll
            for (int bj = 0; bj < 2; ++bj) { const u32x4 xw = x[bj]; const f32x4 g0 = gi[2 * bj] * rr, g1 = gi[2 * bj + 1] * rr;
                f32x4 v0 = acc[ai][bj][m][0], v1 = acc[ai][bj][m][1];
                v0[0] += bflo(xw.x) * g0[0]; v0[1] += bfhi(xw.x) * g0[1]; v0[2] += bflo(xw.y) * g0[2]; v0[3] += bfhi(xw.y) * g0[3];
                v1[0] += bflo(xw.z) * g1[0]; v1[1] += bfhi(xw.z) * g1[1]; v1[2] += bflo(xw.w) * g1[2]; v1[3] += bfhi(xw.w) * g1[3];
                u32x4 w; w.x = cvt_pk_bf16(v0[0], v0[1]); w.y = cvt_pk_bf16(v0[2], v0[3]); w.z = cvt_pk_bf16(v1[0], v1[1]); w.w = cvt_pk_bf16(v1[2], v1[3]);
                *(u32x4*)(rowp + bj * 128) = w;
                const f32x4 f0 = gf[2 * bj], f1 = gf[2 * bj + 1];
                u32x2 uw; uw.x = pk4_fp8(bflo(w.x) * f0[0], bfhi(w.x) * f0[1], bflo(w.y) * f0[2], bfhi(w.y) * f0[3]); uw.y = pk4_fp8(bflo(w.z) * f1[0], bfhi(w.z) * f1[1], bflo(w.w) * f1[2], bfhi(w.w) * f1[3]);
                *(u32x2*)(U2 + base + (size_t)(ai * 128 + m * 16) * 2048 + bj * 128) = uw; } };
        u32x4 x0[2], x1[2], x2[2], x3[2]; float r0, r1, r2, r3;
        ld(0, x0, r0); ld(1, x1, r1); ld(2, x2, r2); ld(3, x3, r3);
        fin(0, x0, r0); ld(4, x0, r0); fin(1, x1, r1); ld(5, x1, r1); fin(2, x2, r2); ld(6, x2, r2); fin(3, x3, r3); ld(7, x3, r3);
        fin(4, x0, r0); fin(5, x1, r1); fin(6, x2, r2); fin(7, x3, r3);
    }
};
}
namespace mk {
__device__ __forceinline__ void p5_router(const Args& a, LAS unsigned char* lds, int vcu, int G, int wave, int lane) {
    unsigned char* ws = a.ws;
    const bf16_t* HB = (const bf16_t*)(ws + WS_H);
    const bf16_t* WH = (const bf16_t*)(ws + WS_SMALL + SM_WG36);
    gu32* cnt = (gu32*)(ws + WS_CTL) + CW_CNT;
    int* PERM = (int*)(ws + WS_SMALL + SM_PERM); float* RSTD = (float*)(ws + WS_SMALL + SM_RSTD); float* GATE = (float*)(ws + WS_SMALL + SM_GATE);
    int* TOKE = (int*)(ws + WS_SMALL + SM_TOKE); int* TOKS = (int*)(ws + WS_SMALL + SM_TOKS);
    const int tid = threadIdx.x, fr = lane & 15, g = lane >> 4, w4 = wave & 3, kh = wave >> 2;
    constexpr int WROW = 264, WBUF = 2 * 48 * WROW * 2;
    LAS float* XP = (LAS float*)(lds + 2 * WBUF + 8192) + w4 * 832;
#define P5_WLOAD(dst, s_) do { _Pragma("unroll") for (int j_ = 0; j_ < 6; ++j_) { const int id_ = tid + 512 * j_; dst[j_] = *(const GAS u32x4*)(WH + (size_t)(id_ >> 5) * 2048 + 256 * (s_) + 8 * (id_ & 31)); } } while (0)
#define P5_WSTORE(src, buf_) do { _Pragma("unroll") for (int j_ = 0; j_ < 6; ++j_) { const int id_ = tid + 512 * j_; *(LAS u32x4*)(lds + (buf_) * WBUF + ((id_ >> 5) * WROW + 8 * (id_ & 31)) * 2) = src[j_]; } } while (0)
    for (int tb = vcu; tb < M / 64; tb += G) {
        const int m0 = tb * 64 + w4 * 16;
        const size_t rowoff = (size_t)(m0 + fr) * 2048 + 128 * kh + 8 * g;
        { u32x4 w0[6]; P5_WLOAD(w0, 0); P5_WSTORE(w0, 0); }
        u32x4 dA[4], dB[4];
#define P5_XLOAD(dst, kk, s_) do { dst[kk] = __builtin_nontemporal_load((const GAS u32x4*)(HB + rowoff + 256 * (s_) + 32 * (kk))); } while (0)
#pragma unroll
        for (int kk = 0; kk < 4; ++kk) { P5_XLOAD(dA, kk, 0); P5_XLOAD(dB, kk, 1); }
        f32x4 acc[3]; acc[0] = acc[1] = acc[2] = (f32x4){0.f, 0.f, 0.f, 0.f}; float ss = 0.f;
        __syncthreads();
#define P5_STAGE(s, dl) do { \
            u32x4 wn[6]; const int sn = (s) < 7 ? (s) + 1 : 7, s2 = (s) < 6 ? (s) + 2 : 7; \
            P5_WLOAD(wn, sn); \
            const LAS unsigned char* wb = lds + ((s) & 1) * WBUF; \
            _Pragma("unroll") for (int kk = 0; kk < 4; ++kk) { \
                const int kl = 128 * kh + 32 * kk + 8 * g;                             \
                const u32x4 d = dl[kk]; \
                P5_XLOAD(dl, kk, s2); \
                f32x4 p, q; p.x = bflo(d.x); p.y = bfhi(d.x); p.z = bflo(d.y); p.w = bfhi(d.y); q.x = bflo(d.z); q.y = bfhi(d.z); q.z = bflo(d.w); q.w = bfhi(d.w); \
                ss += (p.x * p.x + p.y * p.y) + (p.z * p.z + p.w * p.w) + (q.x * q.x + q.y * q.y) + (q.z * q.z + q.w * q.w); \
                const bf16x8 ah = __builtin_bit_cast(bf16x8, d); \
                _Pragma("unroll") for (int nt = 0; nt < 3; ++nt) { const bf16x8 wh = *(const LAS bf16x8*)(wb + ((16 * nt + fr) * WROW + kl) * 2), wl = *(const LAS bf16x8*)(wb + ((48 + 16 * nt + fr) * WROW + kl) * 2); \
                    acc[nt] = __builtin_amdgcn_mfma_f32_16x16x32_bf16(ah, wh, acc[nt], 0, 0, 0); acc[nt] = __builtin_amdgcn_mfma_f32_16x16x32_bf16(ah, wl, acc[nt], 0, 0, 0); } \
            } \
            P5_WSTORE(wn, ((s) + 1) & 1); \
            __syncthreads(); } while (0)
        for (int s = 0; s < 8; s += 2) { P5_STAGE(s, dA); P5_STAGE(s + 1, dB); }
#undef P5_STAGE
        if (kh == 1) {
#pragma unroll
            for (int nt = 0; nt < 3; ++nt)
#pragma unroll
                for (int r = 0; r < 4; ++r) XP[(nt * 4 + r) * 64 + lane] = acc[nt][r];
            XP[12 * 64 + lane] = ss;
        }
        __syncthreads();
        if (kh == 0) {
            ss += XP[12 * 64 + lane];
#pragma unroll
            for (int nt = 0; nt < 3; ++nt)
#pragma unroll
                for (int r = 0; r < 4; ++r) acc[nt][r] += XP[(nt * 4 + r) * 64 + lane];
            ss += __shfl_xor(ss, 16); ss += __shfl_xor(ss, 32);
            const float rstd = 1.0f / sqrtf(ss * (1.f / D) + EPS);
            LDS_WAIT(); asm volatile("" ::: "memory");
            LAS float* LG = XP;
#pragma unroll
            for (int nt = 0; nt < 3; ++nt)
#pragma unroll
                for (int r = 0; r < 4; ++r) LG[(4 * g + r) * 49 + 16 * nt + fr] = acc[nt][r];
            LDS_WAIT(); asm volatile("" ::: "memory");
            if (lane < 16) {
                const LAS float* lg = LG + lane * 49; const int tok = m0 + lane;
                float gl[4]; int grp = 0; float gm = -INFINITY;
#pragma unroll
                for (int j = 0; j < 4; ++j) { gl[j] = lg[j] * rstd + a.in[I_BGRP][j]; if (gl[j] > gm) { gm = gl[j]; grp = j; } }
                float se = 0.f;
#pragma unroll
                for (int j = 0; j < 4; ++j) se += __expf(gl[j] - gm);
                const float pg = 1.f / se;
                float el[8];
#pragma unroll
                for (int j = 0; j < 8; ++j) el[j] = lg[4 + grp * 8 + j] * rstd + a.in[I_BRT][grp * 8 + j];
                int i0 = 0; float v0 = el[0];
#pragma unroll
                for (int j = 1; j < 8; ++j) if (el[j] > v0) { v0 = el[j]; i0 = j; }
                int i1 = -1; float v1 = -INFINITY;
#pragma unroll
                for (int j = 0; j < 8; ++j) if (j != i0 && el[j] > v1) { v1 = el[j]; i1 = j; }
                const float e1 = __expf(v1 - v0); const float g0 = pg / (1.f + e1), g1 = pg * e1 / (1.f + e1);
                const int ea = grp * 8 + i0, eb = grp * 8 + i1;
                const int sa = (int)__hip_atomic_fetch_add(cnt + ea, 1u, RLX_AGENT), sb = (int)__hip_atomic_fetch_add(cnt + eb, 1u, RLX_AGENT);
                PERM[(size_t)ea * ECAP + sa] = tok; PERM[(size_t)eb * ECAP + sb] = tok;
                RSTD[(size_t)ea * ECAP + sa] = rstd; RSTD[(size_t)eb * ECAP + sb] = rstd;
                GATE[tok * 2] = g0; GATE[tok * 2 + 1] = g1;
                TOKE[tok * 2] = ea; TOKE[tok * 2 + 1] = eb; TOKS[tok * 2] = sa; TOKS[tok * 2 + 1] = sb;
            }
        }
        __syncthreads();
    }
#undef P5_WLOAD
#undef P5_WSTORE
#undef P5_XLOAD
}

constexpr int ETAB_OFF = 131072 + 1024;
__device__ __forceinline__ void build_expert_tab(const gu32* cnt, LAS unsigned char* lds, int npn) {
    LAS int* tab = (LAS int*)(lds + ETAB_OFF);
    if (threadIdx.x < 64) { const int lane = threadIdx.x, e = lane & 31;
        const int ce = (int)__hip_atomic_load(cnt + e, RLX_AGENT); const int te = (ce + 255) >> 8;
        int pu = te * npn, pr = te * 256;
#pragma unroll
        for (int o = 1; o < 32; o <<= 1) { const int qu = __shfl_up(pu, o, 32), qr = __shfl_up(pr, o, 32); if (e >= o) { pu += qu; pr += qr; } }
        if (lane < 32) { tab[e] = pu; tab[32 + e] = pr - te * 256; tab[64 + e] = ce; } }
    __syncthreads();
}
struct GroupedBase {
    const LAS int* tab; int KB, G, vcu, NPN, ibase, lofs;
    __device__ __forceinline__ bool locate(int i, pg8::Unit& u) const {
        const int L = (i + ibase) * G + vcu + lofs, lane = threadIdx.x & 31;
        const int pre = tab[lane];
        const unsigned mask = (unsigned)__ballot(pre <= L);
        const int e = __builtin_popcount(mask);
        if (e >= NE) return false;
        const int excl = e ? __builtin_amdgcn_readfirstlane(tab[e - 1]) : 0, rowb = __builtin_amdgcn_readfirstlane(tab[32 + e]), ce = __builtin_amdgcn_readfirstlane(tab[64 + e]);
        const int l = L - excl, te = (ce + 255) >> 8, rt = l % te;
        u.pn = l / te; u.e = e; u.r0 = rt * 256; u.pm = (rowb >> 8) + rt; u.rowbase = rowb + rt * 256; u.rows = ce - rt * 256; u.half = 0; u.dep = te * NPN; return true;
    }
};
struct GateUp : GroupedBase {
    static constexpr bool WAITS = false;
    const unsigned char* U2; const unsigned char* W; const int* perm;
    __device__ bool next(int i, pg8::Unit& u) const { return locate(i, u); }
    __device__ __forceinline__ const void* a_ptr() const { return U2; }
    __device__ __forceinline__ const void* b_ptr() const { return W; }
    __device__ __forceinline__ unsigned a_soff(const pg8::Unit&) const { return 0u; }
    __device__ __forceinline__ unsigned b_soff(const pg8::Unit& u) const { return ((unsigned)u.e * 2048u + (unsigned)u.pn * 256u) * 2048u; }
    __device__ __forceinline__ void a_off(const pg8::Unit& u, const unsigned (&)[2], const int (&stR)[2], const int (&stC)[2], unsigned (&o)[2][2]) const {
#pragma unroll
        for (int h = 0; h < 2; ++h)
#pragma unroll
            for (int i = 0; i < 2; ++i) { int rl = h * 128 + stR[i]; rl = rl < u.rows ? rl : u.rows - 1;
                const int tok = perm[(size_t)u.e * ECAP + u.r0 + rl]; o[h][i] = (unsigned)tok * 2048u + (unsigned)stC[i] * 2u; }
    }
};
struct EpiGateUp {
    static constexpr bool PERM = true, SIGNALS = true;
    unsigned char* ACT; const float* rstd; gu32* done;
    __device__ __forceinline__ void signal(int e) const { if (threadIdx.x == 0) (void)xb_add((unsigned*)(done + 16 * e), 1u); }
    __device__ __forceinline__ void prefetch(const pg8::Unit& u, int wr, int fr, float (&pre)[8]) const {
#pragma unroll
        for (int q = 0; q < 8; ++q) { const int rl = (q >> 2) * 128 + wr * 64 + (q & 3) * 16 + fr; pre[q] = rl < u.rows ? rstd[(size_t)u.e * ECAP + u.r0 + rl] : 0.f; }
    }
    __device__ __forceinline__ void operator()(const f32x4 (&acc)[2][2][4][2], const pg8::Unit& u, int wr, int wc, int fr_, int fq_, const float (&pre)[8]) const {
        int fr = fr_, fq = fq_; asm volatile("" : "+v"(fr), "+v"(fq));
        const int col0 = u.pn * 128 + wc * 32 + 8 * fq;
#pragma unroll
        for (int ai = 0; ai < 2; ++ai)
#pragma unroll
            for (int m = 0; m < 4; ++m) { const int rl = ai * 128 + wr * 64 + m * 16 + fr; const float rs = pre[ai * 4 + m] * (1.f / WSCALE8);
                float v[8];
#pragma unroll
                for (int n = 0; n < 2; ++n) { const f32x4 gt = acc[ai][0][m][n] * rs, up = acc[ai][1][m][n] * rs;
#pragma unroll
                    for (int j = 0; j < 4; ++j) v[4 * n + j] = gt[j] * __builtin_amdgcn_rcpf(1.0f + __expf(-gt[j])) * up[j]; }
                u32x2 w; w.x = pk4_fp8(v[0], v[1], v[2], v[3]); w.y = pk4_fp8(v[4], v[5], v[6], v[7]);
                __hip_atomic_store((GAS unsigned long long*)(ACT + (size_t)(u.rowbase + rl) * 1024 + col0), (unsigned long long)w.x | ((unsigned long long)w.y << 32), RLX_AGENT); }
    }
};
struct Down : GroupedBase {
    static constexpr bool WAITS = true;
    const unsigned char* ACT; const unsigned char* W; gu32* done;
    __device__ __forceinline__ void wait_sync(const pg8::Unit& u, int& state) const {
        if (state) return;
        const int le = threadIdx.x & 31, ce = tab[64 + le], need = ((ce + 255) >> 8) * NPN;
        unsigned sp = 0u;
        for (;;) {
            const int have = (int)xb_ld((unsigned*)(done + 16 * le));
            const unsigned long long ok = __ballot(have >= need);
            if ((unsigned)ok == 0xffffffffu) { state = 1; break; }
            if ((ok >> u.e) & 1ull) break;
            __builtin_amdgcn_s_sleep(8); if (++sp > (1u << 20)) break;
        }
        asm volatile("" ::: "memory");
    }
    __device__ bool next(int i, pg8::Unit& u) const { return locate(i, u); }
    __device__ __forceinline__ const void* a_ptr() const { return ACT; }
    __device__ __forceinline__ const void* b_ptr() const { return W; }
    __device__ __forceinline__ unsigned a_soff(const pg8::Unit& u) const { return (unsigned)u.rowbase * 1024u; }
    __device__ __forceinline__ unsigned b_soff(const pg8::Unit& u) const { return ((unsigned)u.e * 2048u + (unsigned)u.pn * 256u) * 1024u; }
    __device__ __forceinline__ void a_off(const pg8::Unit&, const unsigned (&vA)[2], const int (&)[2], const int (&)[2], unsigned (&o)[2][2]) const {
        const unsigned hs = 128u * 1024u; o[0][0] = vA[0]; o[0][1] = vA[1]; o[1][0] = vA[0] + hs; o[1][1] = vA[1] + hs; }
};
struct EpiDown {
    static constexpr bool PERM = true, SIGNALS = false;
    bf16_t* YB; const float* gate;
    __device__ __forceinline__ void prefetch(const pg8::Unit&, int, int, float (&)[8]) const {}
    __device__ __forceinline__ void operator()(const f32x4 (&acc)[2][2][4][2], const pg8::Unit& u, int wr, int wc, int fr_, int fq_, const float (&pre)[8]) const {
        int fr = fr_, fq = fq_; asm volatile("" : "+v"(fr), "+v"(fq));
        const int col0 = u.pn * 256 + wc * 32 + 8 * fq;
#pragma unroll
        for (int ai = 0; ai < 2; ++ai)
#pragma unroll
            for (int m = 0; m < 4; ++m) { const int rl = ai * 128 + wr * 64 + m * 16 + fr; const float gs = 1.f / WSCALE8;
                bf16_t* rowp = YB + (size_t)(u.rowbase + rl) * 2048 + col0;
#pragma unroll
                for (int bj = 0; bj < 2; ++bj) { const f32x4 v0 = acc[ai][bj][m][0] * gs, v1 = acc[ai][bj][m][1] * gs;
                    u32x4 w; w.x = cvt_pk_bf16(v0[0], v0[1]); w.y = cvt_pk_bf16(v0[2], v0[3]); w.z = cvt_pk_bf16(v1[0], v1[1]); w.w = cvt_pk_bf16(v1[2], v1[3]);
                    *(u32x4*)(rowp + bj * 128) = w; } }
    }
};
__device__ __forceinline__ void p67_experts(const Args& a, LAS unsigned char* lds, int vcu, int G, const XcdBarrier& bar) {
    unsigned char* ws = a.ws;
    build_expert_tab((const gu32*)(ws + WS_CTL) + CW_CNT, lds, 8);
    const LAS int* tab = (const LAS int*)(lds + ETAB_OFF);
    gu32* done = (gu32*)(ws + WS_CTL) + CW_DONE;
    const int NU = __builtin_amdgcn_readfirstlane(tab[31]);
    {   GateUp S; S.tab = tab; S.KB = 2048; S.G = G; S.vcu = vcu; S.NPN = 8; S.ibase = 0; S.lofs = 0;
        S.U2 = ws + WS_U2; S.W = ws + WS_WGU; S.perm = (const int*)(ws + WS_SMALL + SM_PERM);
        EpiGateUp E{ws + WS_OALL, (const float*)(ws + WS_SMALL + SM_RSTD), done};
        pg8::gemm_phase<EpiGateUp, GateUp, true, true>(lds, S, E); }
#ifdef MK_SPLIT67
    xcd_barrier(bar);
#endif
    {   Down S; S.tab = tab; S.KB = 1024; S.G = G; S.vcu = vcu; S.NPN = 8; S.ibase = NU > vcu ? (NU - vcu + G - 1) / G : 0; S.lofs = -NU;
        S.ACT = ws + WS_OALL; S.W = ws + WS_WD; S.done = done;
        EpiDown E{(bf16_t*)(ws + WS_PROJ), (const float*)(ws + WS_SMALL + SM_GATE)};
        pg8::gemm_phase<EpiDown, Down, true, true>(lds, S, E); }
}
__device__ __forceinline__ void p8_final(const Args& a, LAS unsigned char* lds, int vcu, int G, int wave, int lane) {
    unsigned char* ws = a.ws;
    build_expert_tab((const gu32*)(ws + WS_CTL) + CW_CNT, lds, 8);
    const LAS int* RB = (const LAS int*)(lds + ETAB_OFF) + 32;
    const bf16_t* DLT = (const bf16_t*)(ws + WS_H); const bf16_t* YB = (const bf16_t*)(ws + WS_PROJ);
    const int* TOKE = (const int*)(ws + WS_SMALL + SM_TOKE); const int* TOKS = (const int*)(ws + WS_SMALL + SM_TOKS); const float* TOKG = (const float*)(ws + WS_SMALL + SM_GATE);
    const int gw = vcu * 8 + wave, NGW = G * 8;
    if (gw >= M) return;
    const int nrows = (M - gw + NGW - 1) / NGW;
    const GAS f32x4* gf = (const GAS f32x4*)a.in[I_GFINAL] + lane;
    struct Rec { int r0, r1; float g0, g1; };
    auto rowm = [&](int k) { return gw + (k < nrows ? k : nrows - 1) * NGW; };
    auto getrec = [&](int m) { Rec r; r.r0 = RB[TOKE[m * 2]] + TOKS[m * 2]; r.r1 = RB[TOKE[m * 2 + 1]] + TOKS[m * 2 + 1]; r.g0 = TOKG[m * 2]; r.g1 = TOKG[m * 2 + 1]; return r; };
    auto load = [&](int m, const Rec& rc, u32x2 (&d)[8], u32x2 (&pp)[8], u32x2 (&qq)[8]) {
        const GAS u32x2* dr = (const GAS u32x2*)(DLT + (size_t)m * 2048) + lane;
        const GAS u32x2* y0 = (const GAS u32x2*)(YB + (size_t)rc.r0 * 2048) + lane; const GAS u32x2* y1 = (const GAS u32x2*)(YB + (size_t)rc.r1 * 2048) + lane;
#pragma unroll
        for (int j = 0; j < 8; ++j) { d[j] = dr[64 * j]; pp[j] = y0[64 * j]; qq[j] = y1[64 * j]; } };
    auto finish = [&](int m, bool st, const Rec& rc, const u32x2 (&d)[8], const u32x2 (&pp)[8], const u32x2 (&qq)[8]) {
        const float g0 = rc.g0, g1 = rc.g1; f32x4 v[8]; float ss = 0.f;
#pragma unroll
        for (int j = 0; j < 8; ++j) {
            v[j].x = bflo(d[j].x) + g0 * bflo(pp[j].x) + g1 * bflo(qq[j].x); v[j].y = bfhi(d[j].x) + g0 * bfhi(pp[j].x) + g1 * bfhi(qq[j].x);
            v[j].z = bflo(d[j].y) + g0 * bflo(pp[j].y) + g1 * bflo(qq[j].y); v[j].w = bfhi(d[j].y) + g0 * bfhi(pp[j].y) + g1 * bfhi(qq[j].y);
            ss += (v[j].x * v[j].x + v[j].y * v[j].y) + (v[j].z * v[j].z + v[j].w * v[j].w); }
        const float rs = 1.0f / sqrtf(wave_sum(ss) * (1.f / D) + EPS);
        if (st) { GAS f32x4* o = (GAS f32x4*)(a.out + (size_t)m * 2048) + lane;
#pragma unroll
            for (int j = 0; j < 8; ++j) o[64 * j] = v[j] * rs * gf[64 * j]; } };
    u32x2 dA[8], dB[8], pA[8], pB[8], qA[8], qB[8];
    Rec rA = getrec(rowm(0)), rB = getrec(rowm(1));
    load(rowm(0), rA, dA, pA, qA);
    for (int k = 0; k < nrows; k += 2) {
        load(rowm(k + 1), rB, dB, pB, qB);
        const Rec rC = getrec(rowm(k + 2));
        finish(rowm(k), true, rA, dA, pA, qA);
        load(rowm(k + 2), rC, dA, pA, qA);
        const Rec rD = getrec(rowm(k + 3));
        finish(rowm(k + 1), k + 1 < nrows, rB, dB, pB, qB);
        rA = rC; rB = rD;
    }
}
}
namespace mk {
constexpr int NWAVES = 8;
constexpr int RING_BYTES = 131072, LDS_BYTES = 163840, CTLZ_OFF = LDS_BYTES - 1024, MISC_OFF = CTLZ_OFF + 320;
constexpr int NPHASE = 9;

__global__ void __launch_bounds__(NWAVES * 64, 2) mk_fwd(Args args) {
    extern __shared__ __attribute__((aligned(16))) unsigned char lds_raw[];
    LAS unsigned char* lds = (LAS unsigned char*)lds_raw;
    volatile LAS unsigned* MISC = (volatile LAS unsigned*)(lds + MISC_OFF);
    const int tid = threadIdx.x, lane = tid & 63, wave = __builtin_amdgcn_readfirstlane(tid >> 6);
    const int G = gridDim.x; const int bx = blockIdx.x; const int vcu = (G % 8 == 0) ? (bx % 8) * (G / 8) + bx / 8 : bx;
    unsigned char* ws = args.ws;
    gu32* ctl = (gu32*)(ws + WS_CTL);
    for (int u = tid; u < (LDS_BYTES - CTLZ_OFF) / 4; u += NWAVES * 64) ((LAS unsigned*)(lds + CTLZ_OFF))[u] = 0u;
    __syncthreads();
    const int lo = args.ph_lo, hi = args.ph_hi;
    const bool multi = (hi - lo) > 1;
    XcdBarrier bar; bar.bar = (unsigned*)(ctl + CW_BAR); bar.x = 0; bar.st = nullptr;
    if (multi) bar = xcd_barrier_post((unsigned*)(ctl + CW_BAR), MISC + 8);
#define IN(k) (lo <= (k) && (k) < hi)
#define SEAM(k) do { if (IN(k) && IN((k) + 1)) xcd_barrier(bar); } while (0)

#ifndef MK_GG
#define MK_GG 168
#endif
    const int GG = (G == 256) ? MK_GG : G;
#define PH0 { if (GG == G) { p0_prologue<3>(args, lds, vcu * 8 + wave, G * 8, wave, lane); p0_experts(args, lds, vcu * 8 + wave, G * 8, wave, lane); } \
      else p0_prologue<1>(args, lds, vcu * 8 + wave, G * 8, wave, lane); }
#define PH1 { if (bx < GG) { p1_meta(args, lds, bx, GG, wave, lane); \
        pg8::Dense S; S.init((const bf16_t*)(ws + WS_XN), (const bf16_t*)(ws + WS_WIN), M, DIN, D, GG, bx); \
        EpiProj E{ws + WS_PROJ}; pg8::gemm_phase<EpiProj, pg8::Dense, true>(lds, S, E); } \
      else { p0_prologue<2>(args, lds, (bx - GG) * 8 + wave, (G - GG) * 8, wave, lane); p0_experts(args, lds, (bx - GG) * 8 + wave, (G - GG) * 8, wave, lane); } }
#define PH2 { p2_attn_lru(args, lds, lds_raw, vcu, G, wave, lane); }
#define PH3 { p3_combine(args, lds, vcu, G, wave, lane); }
#define PH4 { pg8::Dense S; S.init((const bf16_t*)(ws + WS_MIX), (const bf16_t*)(ws + WS_WOUT), M, D, D, G, bx); \
        EpiH E{(bf16_t*)(ws + WS_H), (const bf16_t*)(ws + WS_XN), (const float*)(ws + WS_SMALL + SM_XRMS), (const float*)(ws + WS_SMALL + SM_GINV), ws + WS_U2, args.in[I_GFFN]}; pg8::gemm_phase<EpiH, pg8::Dense, true>(lds, S, E); }
#define PH5 { p5_router(args, lds, vcu, G, wave, lane); }
#define PH6 { p67_experts(args, lds, vcu, G, bar); }
#define PH7 { }
#define PH8 { p8_final(args, lds, vcu, G, wave, lane); }
#ifndef MK_REPEAT
#define MK_REPEAT -1
#endif
#define RUN(k, BODY) do { if (IN(k)) { BODY if (MK_REPEAT == (k)) { __syncthreads(); BODY } } SEAM(k); } while (0)
    RUN(0, PH0); RUN(1, PH1); RUN(2, PH2);   RUN(4, PH4);
#ifdef MK_EXTRA_BAR
    if (multi) for (int xb_ = 0; xb_ < MK_EXTRA_BAR; ++xb_) xcd_barrier(bar);
#endif
    RUN(5, PH5); RUN(6, PH6);
    if (IN(8)) { PH8 if (MK_REPEAT == 8) { __syncthreads(); PH8 } }
#undef IN
#undef SEAM
}

static int mk_grid() {
    static int grid = 0;
    if (grid == 0) {
        int dev = 0, cus = 0, per_cu = 0;
        (void)hipGetDevice(&dev); (void)hipDeviceGetAttribute(&cus, hipDeviceAttributeMultiprocessorCount, dev);
        (void)hipFuncSetAttribute((const void*)mk_fwd, hipFuncAttributeMaxDynamicSharedMemorySize, LDS_BYTES);
        (void)hipOccupancyMaxActiveBlocksPerMultiprocessor(&per_cu, (const void*)mk_fwd, NWAVES * 64, LDS_BYTES);
        (void)hipGetLastError();
        if (per_cu < 1) per_cu = 1;
        grid = cus * 1;
        if (grid <= 0) grid = 256;
    }
    return grid;
}
static void mk_launch(void* const* d_in, float* out, unsigned char* ws, int lo, int hi, hipStream_t stream) {
    Args a{}; for (int i = 0; i < 27; ++i) a.in[i] = (const float*)d_in[i];
    a.out = out; a.ws = ws; a.ph_lo = lo; a.ph_hi = hi;
    hipLaunchKernelGGL(mk_fwd, dim3(mk_grid()), dim3(NWAVES * 64), LDS_BYTES, stream, a);
}
}
extern "C" void kernel_launch(void* const* d_in, const int* in_sizes, int n_in, void* d_out, int out_size, void* d_ws, size_t ws_size, hipStream_t stream) {
    (void)in_sizes; (void)n_in; (void)out_size; (void)ws_size;
    unsigned char* ws = (unsigned char*)d_ws;
    (void)hipMemsetAsync(ws + mk::WS_CTL, 0, mk::CTL_ZERO_BYTES, stream);
#if MK_ONE_LAUNCH
    mk::mk_launch(d_in, (float*)d_out, ws, 0, mk::NPHASE, stream);
#else
    for (int p = 0; p < mk::NPHASE; ++p) mk::mk_launch(d_in, (float*)d_out, ws, p, p + 1, stream);
#endif
}
```

```cpp
#define MK_STAGE 5
#define MK_ONE_LAUNCH 1
#define MK_REPEAT -1
#include <hip/hip_runtime.h>
#include <hip/hip_bf16.h>
#include <stdint.h>
#include <math.h>

namespace mk {
#define LAS __attribute__((address_space(3)))
#define GAS __attribute__((address_space(1)))
typedef unsigned short bf16_t;
typedef short bf16x8 __attribute__((ext_vector_type(8)));
typedef float f32x4 __attribute__((ext_vector_type(4)));
typedef float f32x2 __attribute__((ext_vector_type(2)));
typedef float f32x16 __attribute__((ext_vector_type(16)));
typedef unsigned u32x4 __attribute__((ext_vector_type(4)));
typedef unsigned u32x2 __attribute__((ext_vector_type(2)));
typedef int i32x4 __attribute__((ext_vector_type(4)));
typedef int i32x8 __attribute__((ext_vector_type(8)));
typedef GAS unsigned gu32;

constexpr int NB = 2, SEQ = 8192, NMETA = 16, D = 2048, M = NB * SEQ;
constexpr int TPAD = 64, TP = SEQ + TPAD, MP = NB * TP;
constexpr int DIN = 5120, DLRU = 1024, DATT = 1024, NH = 8, NE = 32, DE = 1024, NLB = 16;
constexpr int ECAP = M;
constexpr int MAXROWS = 40960;
constexpr float EPS = 1e-6f;
constexpr float LOG2E = 1.4426950408889634f;
constexpr float C2 = 0.125f * LOG2E;
constexpr float WSCALE8 = 64.f;
constexpr int LCH = 128, NCH = SEQ / LCH;

constexpr size_t MiB = 1u << 20;
constexpr size_t WS_CTL = 0, CTL_ZERO_BYTES = 64 * 1024;
constexpr size_t WS_SMALL = 1 * MiB;
constexpr size_t WS_WIN = 17 * MiB;
constexpr size_t WS_WOUT = 37 * MiB;
constexpr size_t WS_WGU = 45 * MiB;
constexpr size_t WS_WD = 301 * MiB;
constexpr size_t WS_XN = 429 * MiB;
constexpr size_t WS_PROJ = 493 * MiB;
constexpr size_t PROJ_TSTRIDE = 33 * MiB;
constexpr size_t WS_OALL = 658 * MiB;
constexpr size_t WS_MIX = 722 * MiB;
constexpr size_t WS_H = 786 * MiB;
constexpr size_t WS_U2 = 850 * MiB;
constexpr size_t WS_END = 914 * MiB;
static_assert((size_t)MP * 1024 * 2 <= PROJ_TSTRIDE && (size_t)MAXROWS * 2048 * 2 <= 5 * PROJ_TSTRIDE && (size_t)MAXROWS * 1024 * 2 <= 128 * MiB, "ws map");
constexpr size_t SM_BIAS = 0;
constexpr size_t SM_WG36 = 64 * 1024;
constexpr size_t SM_XNM = 512 * 1024;
constexpr size_t SM_LRUTOT = 1 * MiB;
constexpr size_t SM_PERM = 2 * MiB;
constexpr size_t SM_RSTD = 4 * MiB;
constexpr size_t SM_GATE = 6 * MiB;
constexpr size_t SM_TOKE = 8 * MiB;
constexpr size_t SM_TOKS = 8 * MiB + 256 * 1024;
constexpr size_t SM_XRMS = 9 * MiB;
constexpr size_t SM_GINV = 9 * MiB + 64 * 1024;
constexpr size_t SM_LRUW = 10 * MiB;
constexpr size_t SM_LRUC = 10 * MiB + 256 * 1024;
constexpr int CW_TMO = 0, CW_CODE = 1, CW_CNT = 8192  , CNT_STRIDE = 64, CW_DONE = 1024  , CW_LRU1 = 2048  , CW_BAR = 4096;

#define RLX_AGENT __ATOMIC_RELAXED, __HIP_MEMORY_SCOPE_AGENT
#define LDS_WAIT() asm volatile("s_waitcnt lgkmcnt(0)" ::: "memory")
#define VM_WAIT() asm volatile("s_waitcnt vmcnt(0)" ::: "memory")
__device__ __forceinline__ unsigned f2bf(float f) { unsigned u = __builtin_bit_cast(unsigned, f); return (u + 0x7fffu + ((u >> 16) & 1u)) >> 16; }
__device__ __forceinline__ unsigned pk2(float lo, float hi) { return f2bf(lo) | (f2bf(hi) << 16); }
__device__ __forceinline__ float bf2f(unsigned short v) { return __builtin_bit_cast(float, (unsigned)v << 16); }
__device__ __forceinline__ float bflo(unsigned v) { return __builtin_bit_cast(float, v << 16); }
__device__ __forceinline__ float bfhi(unsigned v) { return __builtin_bit_cast(float, v & 0xffff0000u); }
__device__ __forceinline__ unsigned cvt_pk_bf16(float lo, float hi) { unsigned r; asm volatile("v_cvt_pk_bf16_f32 %0, %1, %2" : "=v"(r) : "v"(lo), "v"(hi)); return r; }
__device__ __forceinline__ unsigned pk4_fp8(float a, float b, float c, float d) { unsigned w = 0u; w = (unsigned)__builtin_amdgcn_cvt_pk_fp8_f32(a, b, (int)w, false); w = (unsigned)__builtin_amdgcn_cvt_pk_fp8_f32(c, d, (int)w, true); return w; }
__device__ __forceinline__ float wave_sum(float v) {
#pragma unroll
    for (int o = 1; o < 64; o <<= 1) v += __shfl_xor(v, o);
    return v;
}

#define XB_TMO      128
#define XB_XCNT(j)  (256  + 64 * (j))
#define XB_XSUB(j)  (1280 + 64 * (j))
#define XB_XGEN(j)  (2304 + 64 * (j))
#define XB_TOP      3328
#define XB_TOPGEN   3392
#define XCD_BAR_WORDS 3456
#define XB_SPIN_CAP (1u << 18)
__device__ __forceinline__ unsigned xb_ld(unsigned* p)              { return __hip_atomic_load(p, __ATOMIC_RELAXED, __HIP_MEMORY_SCOPE_AGENT); }
__device__ __forceinline__ unsigned xb_add(unsigned* p, unsigned v) { return __hip_atomic_fetch_add(p, v, __ATOMIC_RELAXED, __HIP_MEMORY_SCOPE_AGENT); }
__device__ __forceinline__ unsigned xb_xcc_id() { return (unsigned)__builtin_amdgcn_s_getreg((3 << 11) | 20) & 0xFu; }
#define XB_SPIN(cond, bar) do { unsigned _sp = 0; while (cond) { __builtin_amdgcn_s_sleep(1); \
    if ((++_sp & 255u) == 0u) { if (xb_ld(&(bar)[XB_TMO])) break; if (_sp > XB_SPIN_CAP) { atomicAdd(&(bar)[XB_TMO], 1u); break; } } } } while (0)
struct XcdBarrier { unsigned* bar; unsigned x; volatile LAS unsigned* st; };
__device__ __forceinline__ XcdBarrier xcd_barrier_post(unsigned* bar, volatile LAS unsigned* st) {
    XcdBarrier b; b.bar = bar; b.x = xb_xcc_id(); b.st = st;
    if (threadIdx.x == 0) (void)xb_add(&bar[XB_XCNT(b.x)], 1u);
    return b;
}
__device__ __forceinline__ void xcd_barrier_complete(unsigned* bar, unsigned x, unsigned& nloc, unsigned& nx) {
    const unsigned G = gridDim.x * gridDim.y * gridDim.z;
    unsigned sum, cnt, mine, sp = 0u;
    for (;;) {
        sum = 0u; cnt = 0u; mine = 0u;
#pragma unroll
        for (unsigned j = 0; j < 16; ++j) { const unsigned c = xb_ld(&bar[XB_XCNT(j)]); sum += c; cnt += (c > 0u) ? 1u : 0u; mine = (j == x) ? c : mine; }
        if (sum == G) break;
        __builtin_amdgcn_s_sleep(1);
        if ((++sp & 255u) == 0u) { if (xb_ld(&bar[XB_TMO])) break; if (sp > XB_SPIN_CAP) { atomicAdd(&bar[XB_TMO], 1u); break; } }
    }
    nloc = mine > 0u ? mine : 1u; nx = cnt > 0u ? cnt : 1u;
}
__device__ __forceinline__ void xcd_barrier(const XcdBarrier& b) {
    asm volatile("s_waitcnt vmcnt(0)" ::: "memory");
    __syncthreads();
    if (threadIdx.x == 0) {
        unsigned* bar = b.bar;
        __builtin_amdgcn_s_waitcnt(0);
        unsigned nloc = b.st[0], nx = b.st[1];
        if (nloc == 0u) { xcd_barrier_complete(bar, b.x, nloc, nx); b.st[0] = nloc; b.st[1] = nx; }
        const unsigned old = xb_add(&bar[XB_XSUB(b.x)], 1u);
        const unsigned gen = old / nloc;
        if (old + 1u == (gen + 1u) * nloc) {
            __builtin_amdgcn_fence(__ATOMIC_RELEASE, "agent");
            asm volatile("s_waitcnt vmcnt(0)" ::: "memory");
            const unsigned og = xb_add(&bar[XB_TOP], 1u);
            const unsigned tg = og / nx;
            if (og + 1u == (tg + 1u) * nx) xb_add(&bar[XB_TOPGEN], 1u);
            else XB_SPIN(xb_ld(&bar[XB_TOPGEN]) == tg, bar);
            __builtin_amdgcn_fence(__ATOMIC_ACQUIRE, "agent");
            xb_add(&bar[XB_XGEN(b.x)], 1u);
            asm volatile("s_waitcnt vmcnt(0)" ::: "memory");
        } else {
            XB_SPIN(xb_ld(&bar[XB_XGEN(b.x)]) == gen, bar);
            __builtin_amdgcn_fence(__ATOMIC_ACQUIRE, "agent");
            asm volatile("s_waitcnt vmcnt(0)" ::: "memory");
        }
    }
    __syncthreads();
}

namespace pg8 {
constexpr int BM = 256, BK = 64, HALF = 128, HTB = HALF * BK * 2, STAGE_BYTES = 8 * HTB, NXCD = 8, WGM = 8;
__host__ __device__ __forceinline__ int lds_byte(int r, int c) { const int st = (r >> 4) * 2 + (c >> 5), rr = r & 15, cc = c & 31, ob = rr * 64 + cc * 2; return st * 1024 + (ob ^ (((ob >> 9) & 1) << 5)); }
__host__ __device__ __forceinline__ void stage_rc(int b, int& R, int& C) { const int st = b / 1024, sb = b % 1024, swz = sb ^ (((sb >> 9) & 1) << 5); R = (st >> 1) * 16 + swz / 64; C = (st & 1) * 32 + (swz % 64) / 2; }
__host__ __device__ __forceinline__ int perm32(int rho) { const int n = rho >> 4, i = rho & 15; return 8 * (i >> 2) + 4 * n + (i & 3); }

struct Unit { int pm, pn, e, rows, r0, rowbase, half, dep; };

struct Dense {
    static constexpr bool WAITS = false, GATHER = false, RAGGED = false;
    const bf16_t* A; const bf16_t* Bt; int KB  ; int nM, nN, nwg, G, c, wgm;
    __device__ void init(const bf16_t* A_, const bf16_t* Bt_, int M_, int N_, int K_, int G_, int c_) { A = A_; Bt = Bt_; KB = 2 * K_; nM = M_ / BM; nN = N_ / BM; nwg = nM * nN; G = G_; c = c_; wgm = WGM; }
    __device__ bool next(int i, Unit& u) const {
        const long L = (long)i * G + c; if (L >= nwg) return false;
        int wgid = (int)L; { const int q = nwg / NXCD, r = nwg % NXCD, xcd = wgid % NXCD, off = wgid / NXCD; wgid = (xcd < r ? xcd * (q + 1) : r * (q + 1) + (xcd - r) * q) + off; }
        const int nig = wgm * nN, gid = wgid / nig, fm = gid * wgm, gsz = (nM - fm) < wgm ? (nM - fm) : wgm;
        u.pm = fm + ((wgid % nig) % gsz); u.pn = (wgid % nig) / gsz; u.e = 0; u.rows = BM; u.r0 = 0; u.rowbase = u.pm * BM; u.half = 0; u.dep = 0; return true;
    }
    __device__ __forceinline__ const void* a_ptr() const { return A; }
    __device__ __forceinline__ const void* b_ptr() const { return Bt; }
    __device__ __forceinline__ unsigned a_soff(const Unit& u) const { return (unsigned)u.pm * (2u * (unsigned)HALF * (unsigned)KB); }
    __device__ __forceinline__ unsigned b_soff(const Unit& u) const { return (unsigned)u.pn * (2u * (unsigned)HALF * (unsigned)KB); }
    __device__ __forceinline__ void a_off(const Unit&, const unsigned (&vA)[2], const int (&)[2], const int (&)[2], unsigned (&o)[2][2]) const {
        const unsigned hs = (unsigned)HALF * (unsigned)KB; o[0][0] = vA[0]; o[0][1] = vA[1]; o[1][0] = vA[0] + hs; o[1][1] = vA[1] + hs; }
};

template <class Epi, class Prob, bool ALIGN_EPI, bool FP8 = false>
__device__ __forceinline__ void gemm_phase(LAS unsigned char* lds, const Prob& S, const Epi& E) {
    int tid_ = threadIdx.x; asm volatile("" : "+v"(tid_));
    const int tid = tid_, wid = __builtin_amdgcn_readfirstlane(tid >> 6), lane = tid & 63, wr = wid >> 2, wc = wid & 3, fr = lane & 15, fq = lane >> 4;
    const int KB = S.KB, nt = KB / (BK * 2);
    unsigned voffA[2], voffB[2]; int stR[2], stC[2];
#pragma unroll
    for (int i = 0; i < 2; ++i) { int R, C; stage_rc(tid * 16 + i * 8192, R, C); const int Rb = Epi::PERM ? ((R & ~31) + perm32(R & 31)) : R; stR[i] = R; stC[i] = C;
        voffA[i] = (unsigned)(R * KB + C * 2); voffB[i] = (unsigned)(Rb * KB + C * 2); }
    const unsigned kstep = (unsigned)(BK * 2);
    const unsigned hstep = (unsigned)HALF * (unsigned)KB;
    const __amdgpu_buffer_rsrc_t RA = __builtin_amdgcn_make_buffer_rsrc((void*)S.a_ptr(), 0, 0x7fffffff, 0x00020000), RB = __builtin_amdgcn_make_buffer_rsrc((void*)S.b_ptr(), 0, 0x7fffffff, 0x00020000);
    const unsigned ldsw = (unsigned)wid * 1024u;
    const int aoff = lds_byte(wr * 64 + fr, fq * 8), boff = lds_byte(wc * 32 + fr, fq * 8);
#define PG8_SA(b, h) (((b) * 2 + (h)) * HTB)
#define PG8_SB(b, h) ((4 + (b) * 2 + (h)) * HTB)
#define PG8_STAGE2(bufoff, rs, so, v0, v1) do { \
        __builtin_amdgcn_raw_ptr_buffer_load_lds(rs, (LAS void*)(lds + (bufoff) + ldsw), 16, (int)(v0), (int)(so), 0, 0); \
        __builtin_amdgcn_raw_ptr_buffer_load_lds(rs, (LAS void*)(lds + (bufoff) + ldsw + 8192), 16, (int)(v1), (int)(so), 0, 0); } while (0)
#ifndef MK_BAUX
#define MK_BAUX 0
#endif
#define PG8_STAGEB(bufoff, so) do { \
        __builtin_amdgcn_raw_ptr_buffer_load_lds(RB, (LAS void*)(lds + (bufoff) + ldsw), 16, (int)(voffB[0]), (int)(so), 0, FP8 ? MK_BAUX : 0); \
        __builtin_amdgcn_raw_ptr_buffer_load_lds(RB, (LAS void*)(lds + (bufoff) + ldsw + 8192), 16, (int)(voffB[1]), (int)(so), 0, FP8 ? MK_BAUX : 0); } while (0)
#define PG8_CAT(x_, y_) __builtin_shufflevector((x_), (y_), 0, 1, 2, 3, 4, 5, 6, 7)
#define PG8_LDA(dst, b, h) do { if constexpr (FP8) { _Pragma("unroll") for (int m = 0; m < 4; ++m) dst##8[m] = PG8_CAT(*(const LAS i32x4*)(lds + PG8_SA(b, h) + aoff + m * 2048), *(const LAS i32x4*)(lds + PG8_SA(b, h) + aoff + m * 2048 + 1024)); } \
        else { _Pragma("unroll") for (int m = 0; m < 4; ++m) _Pragma("unroll") for (int k = 0; k < 2; ++k) dst[m][k] = *(const LAS bf16x8*)(lds + PG8_SA(b, h) + aoff + m * 2048 + k * 1024); } } while (0)
#define PG8_LDB(dst, b, h) do { if constexpr (FP8) { _Pragma("unroll") for (int n = 0; n < 2; ++n) dst##8[n] = PG8_CAT(*(const LAS i32x4*)(lds + PG8_SB(b, h) + boff + n * 2048), *(const LAS i32x4*)(lds + PG8_SB(b, h) + boff + n * 2048 + 1024)); } \
        else { _Pragma("unroll") for (int n = 0; n < 2; ++n) _Pragma("unroll") for (int k = 0; k < 2; ++k) dst[n][k] = *(const LAS bf16x8*)(lds + PG8_SB(b, h) + boff + n * 2048 + k * 1024); } } while (0)
#define PG8_MMA(ai, bj, At, Bt) do { __builtin_amdgcn_s_setprio(1); \
        if constexpr (FP8) { _Pragma("unroll") for (int m = 0; m < 4; ++m) _Pragma("unroll") for (int n = 0; n < 2; ++n)   \
            asm volatile("v_mfma_scale_f32_16x16x128_f8f6f4 %0, %1, %2, %0, %3, %3 op_sel_hi:[0,0,0]" : "+v"(acc[ai][bj][m][n]) : "v"(Bt##8[n]), "v"(At##8[m]), "v"(sc1)); } \
        else { _Pragma("unroll") for (int m = 0; m < 4; ++m) _Pragma("unroll") for (int n = 0; n < 2; ++n) _Pragma("unroll") for (int k = 0; k < 2; ++k) \
            acc[ai][bj][m][n] = __builtin_amdgcn_mfma_f32_16x16x32_bf16(Bt[n][k], At[m][k], acc[ai][bj][m][n], 0, 0, 0); } \
        __builtin_amdgcn_s_setprio(0); } while (0)
#define PG8_WAIT_V(n) asm volatile("s_waitcnt vmcnt(" #n ")" ::: "memory")
#define PG8_WAIT_L(n) asm volatile("s_waitcnt lgkmcnt(" #n ")" ::: "memory")
#define PG8_BAR __builtin_amdgcn_s_barrier()
#define PG8_SCHED __builtin_amdgcn_sched_barrier(0)
    Unit cur, nxt; int ui = 0;
    if (!S.next(0, cur)) return;
    int wstate = 0;
    if constexpr (Prob::WAITS) S.wait_sync(cur, wstate);
    bool pend = false; int pend_e = 0;
    f32x4 acc[2][2][4][2];
#pragma unroll
    for (int a = 0; a < 2; ++a)
#pragma unroll
        for (int b = 0; b < 2; ++b)
#pragma unroll
            for (int m = 0; m < 4; ++m)
#pragma unroll
                for (int n = 0; n < 2; ++n) acc[a][b][m][n] = (f32x4){0.f, 0.f, 0.f, 0.f};
    unsigned sc1 = 0x7f7f7f7fu; asm volatile("" : "+v"(sc1));
    bf16x8 At[4][2], B0[2][2], B1[2][2]; i32x8 At8[4], B08[2], B18[2];
    unsigned cA = (unsigned)__builtin_amdgcn_readfirstlane((int)S.a_soff(cur)), cB = (unsigned)__builtin_amdgcn_readfirstlane((int)S.b_soff(cur));
    unsigned cO[2][2], nO[2][2];
    S.a_off(cur, voffA, stR, stC, cO);
    PG8_STAGEB(PG8_SB(0, 0), cB); PG8_STAGEB(PG8_SB(0, 1), cB + hstep); PG8_STAGE2(PG8_SA(0, 0), RA, cA, cO[0][0], cO[0][1]); PG8_STAGE2(PG8_SA(0, 1), RA, cA, cO[1][0], cO[1][1]);
    if (wr == 1) PG8_BAR;
    PG8_WAIT_V(2); PG8_BAR;
    PG8_STAGEB(PG8_SB(1, 0), cB + kstep); PG8_STAGE2(PG8_SA(1, 0), RA, cA + kstep, cO[0][0], cO[0][1]); PG8_STAGEB(PG8_SB(1, 1), cB + hstep + kstep);
    PG8_WAIT_V(6); PG8_BAR;
    for (;;) {
        const bool has_next = S.next(ui + 1, nxt);
        bool hskip = false;
        if constexpr (Prob::RAGGED) hskip = __builtin_amdgcn_readfirstlane(cur.rows) <= 128;
        if constexpr (Prob::WAITS) { if (has_next) S.wait_sync(nxt, wstate); }
        unsigned nA = cA, nB = cB;
        if (has_next) { nA = (unsigned)__builtin_amdgcn_readfirstlane((int)S.a_soff(nxt)); nB = (unsigned)__builtin_amdgcn_readfirstlane((int)S.b_soff(nxt)); }
        nO[0][0] = cO[0][0]; nO[0][1] = cO[0][1]; nO[1][0] = cO[1][0]; nO[1][1] = cO[1][1];
        if constexpr (Prob::GATHER) { if (has_next) S.a_off(nxt, voffA, stR, stC, nO); }
        float pre[8];
#pragma unroll
        for (int q = 0; q < 8; ++q) pre[q] = 0.f;
        for (int t = 0; t < nt; t += 2) {
            const bool last = (t == nt - 2);
            if constexpr (!Prob::GATHER) { if (has_next && t == nt - 4) S.a_off(nxt, voffA, stR, stC, nO); }
            if (last) { int l1 = (int)__builtin_amdgcn_mbcnt_hi(~0u, __builtin_amdgcn_mbcnt_lo(~0u, 0u)); asm volatile("" : "+v"(l1)); E.prefetch(cur, wr, l1 & 15, pre); }
            const unsigned a1 = cA + (unsigned)(t + 1) * kstep;
            const unsigned a2 = last ? nA : cA + (unsigned)(t + 2) * kstep, b2 = last ? nB : cB + (unsigned)(t + 2) * kstep;
            const unsigned a3 = a2 + kstep, b3 = b2 + kstep;
            const unsigned s00 = last ? nO[0][0] : cO[0][0], s01 = last ? nO[0][1] : cO[0][1], s10 = last ? nO[1][0] : cO[1][0], s11 = last ? nO[1][1] : cO[1][1];
            PG8_LDB(B0, 0, 0); PG8_LDB(B1, 0, 1); PG8_SCHED; PG8_LDA(At, 0, 0); PG8_STAGE2(PG8_SA(1, 1), RA, a1, cO[1][0], cO[1][1]);
            PG8_WAIT_V(8); PG8_WAIT_L(0); PG8_BAR; PG8_MMA(0, 0, At, B0); PG8_MMA(0, 1, At, B1); PG8_BAR; PG8_SCHED;
            if (!hskip) PG8_LDA(At, 0, 1); PG8_STAGEB(PG8_SB(0, 0), b2); PG8_STAGEB(PG8_SB(0, 1), b2 + hstep); PG8_STAGE2(PG8_SA(0, 0), RA, a2, s00, s01);
            PG8_WAIT_V(8); PG8_WAIT_L(0); PG8_BAR; if (!hskip) { PG8_MMA(1, 0, At, B0); PG8_MMA(1, 1, At, B1); } PG8_BAR; PG8_SCHED;
            PG8_LDB(B0, 1, 0); PG8_LDB(B1, 1, 1); PG8_SCHED; PG8_LDA(At, 1, 0); PG8_STAGE2(PG8_SA(0, 1), RA, a2, s10, s11);
            PG8_WAIT_V(8); PG8_WAIT_L(0); PG8_BAR; PG8_MMA(0, 0, At, B0); PG8_MMA(0, 1, At, B1); PG8_BAR; PG8_SCHED;
            if (!hskip) PG8_LDA(At, 1, 1); PG8_STAGEB(PG8_SB(1, 0), b3); PG8_STAGEB(PG8_SB(1, 1), b3 + hstep); PG8_STAGE2(PG8_SA(1, 0), RA, a3, s00, s01);
            PG8_WAIT_V(8); PG8_WAIT_L(0); PG8_BAR; if (!hskip) { PG8_MMA(1, 0, At, B0); PG8_MMA(1, 1, At, B1); } PG8_BAR; PG8_SCHED;
        }
        if constexpr (ALIGN_EPI) { if (wr == 0) PG8_BAR; }
        if constexpr (FP8) {
            asm volatile("s_nop 15\n\ts_nop 7" : "+v"(acc[0][0][0][0]), "+v"(acc[0][0][0][1]), "+v"(acc[0][0][1][0]), "+v"(acc[0][0][1][1]), "+v"(acc[0][0][2][0]), "+v"(acc[0][0][2][1]), "+v"(acc[0][0][3][0]), "+v"(acc[0][0][3][1]));
            asm volatile("" : "+v"(acc[0][1][0][0]), "+v"(acc[0][1][0][1]), "+v"(acc[0][1][1][0]), "+v"(acc[0][1][1][1]), "+v"(acc[0][1][2][0]), "+v"(acc[0][1][2][1]), "+v"(acc[0][1][3][0]), "+v"(acc[0][1][3][1]));
            asm volatile("" : "+v"(acc[1][0][0][0]), "+v"(acc[1][0][0][1]), "+v"(acc[1][0][1][0]), "+v"(acc[1][0][1][1]), "+v"(acc[1][0][2][0]), "+v"(acc[1][0][2][1]), "+v"(acc[1][0][3][0]), "+v"(acc[1][0][3][1]));
            asm volatile("" : "+v"(acc[1][1][0][0]), "+v"(acc[1][1][0][1]), "+v"(acc[1][1][1][0]), "+v"(acc[1][1][1][1]), "+v"(acc[1][1][2][0]), "+v"(acc[1][1][2][1]), "+v"(acc[1][1][3][0]), "+v"(acc[1][1][3][1]));
        }
        if constexpr (Epi::SIGNALS) { if (pend) { E.signal(pend_e); pend = false; } }
        { int l2 = (int)__builtin_amdgcn_mbcnt_hi(~0u, __builtin_amdgcn_mbcnt_lo(~0u, 0u)); asm volatile("" : "+v"(l2));
          E(acc, cur, wr, wc, l2 & 15, l2 >> 4, pre); }
#ifdef MK_EPI2
        asm volatile("" ::: "memory"); E(acc, cur, wr, wc, fr, fq, pre);
#endif
        if constexpr (Epi::SIGNALS) { pend = true; pend_e = cur.e; }
        if (!has_next) break;
#pragma unroll
        for (int a = 0; a < 2; ++a)
#pragma unroll
            for (int b = 0; b < 2; ++b)
#pragma unroll
                for (int m = 0; m < 4; ++m)
#pragma unroll
                    for (int n = 0; n < 2; ++n) acc[a][b][m][n] = (f32x4){0.f, 0.f, 0.f, 0.f};
        cur = nxt; cA = nA; cB = nB; ++ui;
        cO[0][0] = nO[0][0]; cO[0][1] = nO[0][1]; cO[1][0] = nO[1][0]; cO[1][1] = nO[1][1];
        if constexpr (ALIGN_EPI) { if (wr == 1) PG8_BAR; }
    }
    PG8_WAIT_V(0);
    if constexpr (!ALIGN_EPI) { if (wr == 0) PG8_BAR; }
    PG8_BAR;
    if constexpr (Epi::SIGNALS) { if (pend) E.signal(pend_e); }
#undef PG8_SA
#undef PG8_SB
#undef PG8_STAGE2
#undef PG8_STAGEB
#undef PG8_LDA
#undef PG8_LDB
#undef PG8_MMA
#undef PG8_CAT
#undef PG8_WAIT_V
#undef PG8_WAIT_L
#undef PG8_BAR
#undef PG8_SCHED
}
}
}
namespace mk {
struct Args { const float* in[27]; float* out; unsigned char* ws; int ph_lo, ph_hi; };

enum { I_X = 0, I_META, I_GMIX, I_WIN, I_CONVW, I_CONVB, I_WR, I_BR, I_WI, I_BI, I_LRUL, I_LQ1, I_LK1, I_LQ2, I_LK2, I_SUBLN, I_RELB, I_WOUT, I_GFFN, I_WGRP, I_BGRP, I_WRT, I_BRT, I_WGATE, I_WUP, I_WDOWN, I_GFINAL };

struct TItem { const float* src; bf16_t* dst; int N, K, k0, n0, rm; };
__device__ __forceinline__ int titem_row(int rm, int n) { return rm == 0 ? n : (n >= 2048 ? n - 2048 : n + 3072); }
__device__ __forceinline__ void titem_load(const TItem& t, int lane, f32x4 (&v)[8]) {
    const int kr = lane >> 3, c4 = (lane & 7) * 4;
#pragma unroll
    for (int i = 0; i < 8; ++i) v[i] = __builtin_nontemporal_load((const GAS f32x4*)(t.src + (size_t)(t.k0 + 8 * i + kr) * t.N + t.n0 + c4));
}
__device__ __forceinline__ void titem_store(const TItem& t, int lane, const f32x4 (&v)[8], LAS float* scr) {
    const int kr = lane >> 3, c4 = (lane & 7) * 4;
#pragma unroll
    for (int i = 0; i < 8; ++i) { LAS float* d = scr + (8 * i + kr) * 33 + c4; d[0] = v[i].x; d[1] = v[i].y; d[2] = v[i].z; d[3] = v[i].w; }
    LDS_WAIT(); asm volatile("" ::: "memory");
    const int c = lane & 7;
#pragma unroll
    for (int j = 0; j < 4; ++j) { const int n = (lane >> 3) + 8 * j; const LAS float* s = scr + (8 * c) * 33 + n;
        u32x4 o; o.x = cvt_pk_bf16(s[0 * 33], s[1 * 33]); o.y = cvt_pk_bf16(s[2 * 33], s[3 * 33]); o.z = cvt_pk_bf16(s[4 * 33], s[5 * 33]); o.w = cvt_pk_bf16(s[6 * 33], s[7 * 33]);
        *(GAS u32x4*)(t.dst + (size_t)titem_row(t.rm, t.n0 + n) * t.K + t.k0 + 8 * c) = o; }
    LDS_WAIT(); asm volatile("" ::: "memory");
}

__device__ __forceinline__ int titem8_row(int rm, int n) { return rm == 0 ? n : 256 * (n >> 7) + (n & 127) + (rm == 5 ? 128 : 0); }
__device__ __forceinline__ void titem8_load(const TItem& t, int lane, f32x4 (&v)[16]) {
    const int kr = lane >> 3, c4 = (lane & 7) * 4;
#pragma unroll
    for (int i = 0; i < 16; ++i) v[i] = __builtin_nontemporal_load((const GAS f32x4*)(t.src + (size_t)(t.k0 + 32 * (i >> 2) + 4 * kr + (i & 3)) * t.N + t.n0 + c4));
}
__device__ __forceinline__ void titem8_store(const TItem& t, int lane, const f32x4 (&v)[16], LAS float* scr) {
    const int kr = lane >> 3, c = lane & 7;
    LAS unsigned char* sb = (LAS unsigned char*)scr;
#pragma unroll
    for (int a = 0; a < 4; ++a) {
        unsigned d[4];
#pragma unroll
        for (int e = 0; e < 4; ++e) { const f32x4 w = v[4 * a + e]; d[e] = pk4_fp8(w.x * WSCALE8, w.y * WSCALE8, w.z * WSCALE8, w.w * WSCALE8); }
        const unsigned x0 = __builtin_amdgcn_perm(d[1], d[0], 0x05010400u), x1 = __builtin_amdgcn_perm(d[1], d[0], 0x07030602u);
        const unsigned y0 = __builtin_amdgcn_perm(d[3], d[2], 0x05010400u), y1 = __builtin_amdgcn_perm(d[3], d[2], 0x07030602u);
        const unsigned tq[4] = {__builtin_amdgcn_perm(y0, x0, 0x05040100u), __builtin_amdgcn_perm(y0, x0, 0x07060302u), __builtin_amdgcn_perm(y1, x1, 0x05040100u), __builtin_amdgcn_perm(y1, x1, 0x07060302u)};
#pragma unroll
        for (int m = 0; m < 4; ++m) *(LAS unsigned*)(sb + (4 * c + m) * 136 + 32 * a + 4 * kr) = tq[m];
    }
    LDS_WAIT(); asm volatile("" ::: "memory");
    unsigned char* dst = (unsigned char*)t.dst;
#pragma unroll
    for (int j = 0; j < 4; ++j) { const int n = (lane >> 3) + 8 * j; const LAS u32x2* s = (const LAS u32x2*)(sb + n * 136 + 16 * c);
        const u32x2 lo = s[0], hi = s[1]; u32x4 o; o.x = lo.x; o.y = lo.y; o.z = hi.x; o.w = hi.y;
        __builtin_nontemporal_store(o, (GAS u32x4*)(dst + (size_t)titem8_row(t.rm, t.n0 + n) * t.K + t.k0 + 16 * c)); }
    LDS_WAIT(); asm volatile("" ::: "memory");
}

__device__ __forceinline__ void rms_row_bf16(const float* xrow, const float* g, bf16_t* orow, int lane, float* rms_out = nullptr) {
    const GAS f32x4* xr = (const GAS f32x4*)xrow + lane; const GAS f32x4* gr = (const GAS f32x4*)g + lane;
    f32x4 v[8]; float s = 0.f;
#pragma unroll
    for (int j = 0; j < 8; ++j) { v[j] = __builtin_nontemporal_load(xr + 64 * j); s += (v[j].x * v[j].x + v[j].y * v[j].y) + (v[j].z * v[j].z + v[j].w * v[j].w); }
    const float rms = sqrtf(wave_sum(s) * (1.f / D) + EPS), rs = 1.0f / rms;
    if (rms_out && lane == 0) *rms_out = rms;
    GAS u32x2* o = (GAS u32x2*)orow + lane;
#pragma unroll
    for (int j = 0; j < 8; ++j) { const f32x4 g4 = gr[64 * j]; u32x2 w; w.x = pk2(v[j].x * rs * g4.x, v[j].y * rs * g4.y); w.y = pk2(v[j].z * rs * g4.z, v[j].w * rs * g4.w); o[64 * j] = w; }
}

__device__ __forceinline__ void p0_experts(const Args& a, LAS unsigned char* lds, int worker, int nworkers, int wave, int lane) {
    unsigned char* ws = a.ws;
    LAS float* scr = (LAS float*)(lds + wave * 20352);
    constexpr int I_E8 = 512, I_G8 = NE * I_E8, NITEMS8 = 3 * I_G8;
    unsigned char* WGU = ws + WS_WGU; unsigned char* WD = ws + WS_WD;
    auto decode8 = [&](int it, TItem& t) {
        int r = it, nblk;
        if (r < I_G8) { const int e = r / I_E8; r %= I_E8; t.src = a.in[I_WGATE] + (size_t)e * D * DE; t.dst = (bf16_t*)(WGU + (size_t)e * 2048 * D); t.K = D; t.N = DE; t.rm = 4; nblk = DE / 32; }
        else if ((r -= I_G8) < I_G8) { const int e = r / I_E8; r %= I_E8; t.src = a.in[I_WUP] + (size_t)e * D * DE; t.dst = (bf16_t*)(WGU + (size_t)e * 2048 * D); t.K = D; t.N = DE; t.rm = 5; nblk = DE / 32; }
        else { r -= I_G8; const int e = r / I_E8; r %= I_E8; t.src = a.in[I_WDOWN] + (size_t)e * DE * D; t.dst = (bf16_t*)(WD + (size_t)e * D * DE); t.K = DE; t.N = D; t.rm = 0; nblk = D / 32; }
        t.k0 = 128 * (r / nblk); t.n0 = 32 * (r % nblk);
    };
    if (worker < NITEMS8) {
        TItem ta, tb; f32x4 va[16], vb[16];
        decode8(worker, ta); titem8_load(ta, lane, va);
        for (int it = worker; it < NITEMS8; it += 2 * nworkers) {
            const int i1 = it + nworkers < NITEMS8 ? it + nworkers : it, i2 = it + 2 * nworkers < NITEMS8 ? it + 2 * nworkers : it;
            decode8(i1, tb); titem8_load(tb, lane, vb);
            titem8_store(ta, lane, va, scr);
            decode8(i2, ta); titem8_load(ta, lane, va);
            titem8_store(tb, lane, vb, scr);
        }
    }
}
template <int PART>
__device__ __forceinline__ void p0_prologue(const Args& a, LAS unsigned char* lds, int gw, int NGW, int wave, int lane) {
    unsigned char* ws = a.ws;
    LAS float* scr = (LAS float*)(lds + wave * 20352);
    constexpr int I_IN = 32 * 160, I_OUT = 32 * 64, IT_LO = (PART & 1) ? 0 : I_IN, NITEMS = (PART & 2) ? I_IN + I_OUT : I_IN;
    bf16_t* WIN = (bf16_t*)(ws + WS_WIN); bf16_t* WOUT = (bf16_t*)(ws + WS_WOUT);
    auto decode = [&](int it, TItem& t) {
        int r = it, nblk;
        if (r < I_IN) { t.src = a.in[I_WIN]; t.dst = WIN; t.K = D; t.N = DIN; t.rm = 1; nblk = DIN / 32; }
        else { r -= I_IN; t.src = a.in[I_WOUT]; t.dst = WOUT; t.K = D; t.N = D; t.rm = 0; nblk = D / 32; }
        t.k0 = 64 * (r / nblk); t.n0 = 32 * (r % nblk);
    };
    if (IT_LO + gw < NITEMS) {
        TItem cur, nxt; f32x4 v[8], vn[8];
        decode(IT_LO + gw, cur); titem_load(cur, lane, v);
        for (int it = IT_LO + gw; it < NITEMS; it += NGW) {
            const int nit = it + NGW < NITEMS ? it + NGW : it;
            decode(nit, nxt); titem_load(nxt, lane, vn);
            titem_store(cur, lane, v, scr);
            cur = nxt;
#pragma unroll
            for (int i = 0; i < 8; ++i) v[i] = vn[i];
        }
    }
    bf16_t* XN = (bf16_t*)(ws + WS_XN); bf16_t* XNM = (bf16_t*)(ws + WS_SMALL + SM_XNM);
    if ((PART & 1) && gw < M + NMETA) {
        f32x4 gv[8];
        { const GAS f32x4* gr = (const GAS f32x4*)a.in[I_GMIX] + lane;
#pragma unroll
          for (int j = 0; j < 8; ++j) gv[j] = gr[64 * j]; }
        const int nrow = (M + NMETA - gw + NGW - 1) / NGW;
        auto rowm = [&](int k) { return gw + (k < nrow ? k : nrow - 1) * NGW; };
        auto ldrow = [&](int m, f32x4 (&v)[8]) { const GAS f32x4* xr = (const GAS f32x4*)(m < M ? a.in[I_X] + (size_t)m * D : a.in[I_META] + (size_t)(m - M) * D) + lane;
#pragma unroll
            for (int j = 0; j < 8; ++j) v[j] = __builtin_nontemporal_load(xr + 64 * j); };
        auto finrow = [&](int m, bool st, const f32x4 (&v)[8]) { float s = 0.f;
#pragma unroll
            for (int j = 0; j < 8; ++j) s += (v[j].x * v[j].x + v[j].y * v[j].y) + (v[j].z * v[j].z + v[j].w * v[j].w);
            const float rms = sqrtf(wave_sum(s) * (1.f / D) + EPS), rs = 1.0f / rms;
            if (st) { if (m < M && lane == 0) ((float*)(ws + WS_SMALL + SM_XRMS))[m] = rms;
                GAS u32x2* o = (GAS u32x2*)(m < M ? XN + (size_t)m * D : XNM + (size_t)(m - M) * D) + lane;
#pragma unroll
                for (int j = 0; j < 8; ++j) { u32x2 w; w.x = pk2(v[j].x * rs * gv[j].x, v[j].y * rs * gv[j].y); w.y = pk2(v[j].z * rs * gv[j].z, v[j].w * rs * gv[j].w); o[64 * j] = w; } } };
        f32x4 va[8], vb[8];
        ldrow(rowm(0), va);
        for (int k = 0; k < nrow; k += 2) {
            ldrow(rowm(k + 1), vb);
            finrow(rowm(k), true, va);
            ldrow(rowm(k + 2), va);
            finrow(rowm(k + 1), k + 1 < nrow, vb);
        }
    }
    if (!(PART & 2)) return;
    const int gt = gw * 64 + lane, NT = NGW * 64;
    bf16_t* WH = (bf16_t*)(ws + WS_SMALL + SM_WG36); bf16_t* WL = WH + 48 * D;
    for (int i = gt; i < D * 48; i += NT) { const int j = i / D, d = i % D; float w = 0.f; if (j < 4) w = a.in[I_WGRP][d * 4 + j]; else if (j < 36) w = a.in[I_WRT][d * 32 + (j - 4)]; w *= a.in[I_GFFN][d];
        const unsigned hb = f2bf(w); const float hf = __builtin_bit_cast(float, hb << 16); WH[i] = (bf16_t)hb; WL[i] = (bf16_t)f2bf(w - hf); }
    { float* GI = (float*)(ws + WS_SMALL + SM_GINV); for (int i = gt; i < D; i += NT) GI[i] = 1.0f / a.in[I_GMIX][i]; }
    {   u32x4* LW = (u32x4*)(ws + WS_SMALL + SM_LRUW);
        for (int i = gt; i < 16 * 2 * 4 * 2 * 64; i += NT) { const int ln = i & 63, kk = (i >> 6) & 1, nt = (i >> 7) & 3, mat = (i >> 9) & 1, blk = i >> 10, fr = ln & 15, g = ln >> 4;
            const float* W = (mat ? a.in[I_WI] : a.in[I_WR]) + (size_t)blk * 4096; float t[8];
#pragma unroll
            for (int j = 0; j < 8; ++j) t[j] = -LOG2E * W[(32 * kk + 8 * g + j) * 64 + 16 * nt + fr];
            u32x4 w; w.x = cvt_pk_bf16(t[0], t[1]); w.y = cvt_pk_bf16(t[2], t[3]); w.z = cvt_pk_bf16(t[4], t[5]); w.w = cvt_pk_bf16(t[6], t[7]); LW[i] = w; }
        float* LC = (float*)(ws + WS_SMALL + SM_LRUC);
        for (int i = gt; i < 1024; i += NT) { LC[i] = -LOG2E * a.in[I_BR][i]; LC[1024 + i] = -LOG2E * a.in[I_BI][i];
            const float L = a.in[I_LRUL][i]; LC[2048 + i] = (8.f * LOG2E) * (fminf(L, 0.f) - log1pf(expf(-fabsf(L)))); } }
    float* BT = (float*)(ws + WS_SMALL + SM_BIAS);
    for (int i = gt; i < NH * 132; i += NT) { const int h = i / 132, idx = i % 132; float v;
        if (idx == 0) v = -INFINITY; else if (idx >= 129) v = 0.f;
        else { const int n = idx - 1; int bucket; if (n < 16) bucket = n; else { int lg = 16 + (int)(logf((float)n / 16.f) / 2.0794415416798357f * 16.f); bucket = lg < 31 ? lg : 31; }
            v = (a.in[I_RELB][bucket * NH + h] - a.in[I_RELB][31 * NH + h]) * LOG2E; }
        BT[i] = v; }
    for (int i = gt; i < 3 * NB * 48 * 128; i += NT) { const int t = 1 + i / (NB * 48 * 128), r = i % (NB * 48 * 128), b = r / (48 * 128), q = r % (48 * 128);
        *(GAS u32x4*)(ws + WS_PROJ + (size_t)t * PROJ_TSTRIDE + ((size_t)b * TP * 1024 + (size_t)q * 8) * 2) = (u32x4){0u, 0u, 0u, 0u}; }
}

__device__ __forceinline__ void p1_meta(const Args& a, LAS unsigned char* lds, int vcu, int G, int wave, int lane) {
    unsigned char* ws = a.ws;
    const bf16_t* XNM = (const bf16_t*)(ws + WS_SMALL + SM_XNM); const bf16_t* WIN = (const bf16_t*)(ws + WS_WIN);
    LAS f32x4* PS = (LAS f32x4*)lds;
    for (int task = vcu; task < 192; task += G) {
        const int n0 = 1024 + task * 16, r = lane & 15, kq = lane >> 4;
        const GAS bf16x8* ap = (const GAS bf16x8*)(XNM + (size_t)r * D + wave * 256 + kq * 8); const GAS bf16x8* bp = (const GAS bf16x8*)(WIN + (size_t)(n0 + r) * D + wave * 256 + kq * 8);
        f32x4 acc = (f32x4){0.f, 0.f, 0.f, 0.f};
#pragma unroll
        for (int kk = 0; kk < 8; ++kk) acc = __builtin_amdgcn_mfma_f32_16x16x32_bf16(ap[kk * 4], bp[kk * 4], acc, 0, 0, 0);
        PS[wave * 64 + lane] = acc;
        __syncthreads();
        if (wave == 0) {
#pragma unroll
            for (int w = 1; w < 8; ++w) acc += PS[w * 64 + lane];
            const int t = n0 >> 10, col = (n0 & 1023) + r;
            bf16_t* T = (bf16_t*)(ws + WS_PROJ + (size_t)t * PROJ_TSTRIDE);
#pragma unroll
            for (int b = 0; b < NB; ++b)
#pragma unroll
                for (int i = 0; i < 4; ++i) T[((size_t)b * TP + 48 + 4 * kq + i) * 1024 + col] = (bf16_t)f2bf(acc[i]);
        }
        __syncthreads();
    }
}

struct EpiProj {
    static constexpr bool PERM = true, SIGNALS = false;
    unsigned char* base;
    __device__ __forceinline__ void prefetch(const pg8::Unit&, int, int, float (&)[8]) const {}
    __device__ __forceinline__ void operator()(const f32x4 (&acc)[2][2][4][2], const pg8::Unit& u, int wr, int wc, int fr_, int fq_, const float (&pre)[8]) const {
        int fr = fr_, fq = fq_; asm volatile("" : "+v"(fr), "+v"(fq));
        const int b = u.pm >> 5; const int row0 = u.pm * 256 + wr * 64 + fr + TPAD * (b + 1);
        const int t = u.pn >> 2; const float sc = (t == 0) ? C2 : 1.f;
        bf16_t* T = (bf16_t*)(base + (size_t)t * PROJ_TSTRIDE);
        const int col0 = (u.pn & 3) * 256 + wc * 32 + 8 * fq;
#pragma unroll
        for (int ai = 0; ai < 2; ++ai)
#pragma unroll
            for (int m = 0; m < 4; ++m) { bf16_t* rowp = T + (size_t)(row0 + ai * 128 + m * 16) * 1024 + col0;
#pragma unroll
                for (int bj = 0; bj < 2; ++bj) { const f32x4 v0 = acc[ai][bj][m][0] * sc, v1 = acc[ai][bj][m][1] * sc;
                    u32x4 w; w.x = cvt_pk_bf16(v0[0], v0[1]); w.y = cvt_pk_bf16(v0[2], v0[3]); w.z = cvt_pk_bf16(v1[0], v1[1]); w.w = cvt_pk_bf16(v1[2], v1[3]);
                    *(u32x4*)(rowp + bj * 128) = w; } }
    }
};
}
namespace attn2 {
using bf16=__hip_bfloat16;
using s16x4=__attribute__((ext_vector_type(4)))short;
using mk::bf16x8; using mk::f32x16; using mk::u32x4;
constexpr int D=64,DM=1024,OP=1024;
constexpr int NW=8,QBLK=32,QB=QBLK*NW,KVBLK=64;
__device__ __forceinline__ int crow(int r,int hi){return (r&3)+8*(r>>2)+4*hi;}
#define SBAR() __builtin_amdgcn_sched_barrier(0)
typedef __attribute__((address_space(3))) const float* lds_fptr;
constexpr int TB4N=656, TB4R=391;
template<bool FIRST> __device__ __forceinline__ void biasmask4(f32x16&p0,f32x16&p1,int t,int rq,int hi,const __attribute__((address_space(3))) char* tb4){
  int hi2=hi; asm volatile("":"+v"(hi2)); const int kb=64*t+4*hi2;
  int j0=TB4R-rq+kb; if(FIRST)j0=j0<0?0:j0;
  const __attribute__((address_space(3))) char* a=tb4+(j0&3)*(TB4N*4)+(j0&~3)*4;
  #pragma unroll
  for(int g=0;g<4;++g){ const mk::f32x4 v=*(const __attribute__((address_space(3))) mk::f32x4*)(a+32*g), w=*(const __attribute__((address_space(3))) mk::f32x4*)(a+128+32*g);
    #pragma unroll
    for(int e=0;e<4;++e){ p0[4*g+e]+=v[e]; p1[4*g+e]+=w[e]; } }
  if(FIRST){
    #pragma unroll
    for(int r=0;r<16;++r){ const int kv=kb+(r&3)+8*(r>>2); p0[r]=-INFINITY; if(kv+32<48)p1[r]=-INFINITY; } }
}
template<bool FIRST> __device__ __forceinline__ void biasmask(f32x16&p0,f32x16&p1,int t,int rq,int hi,lds_fptr tab){
  int hi2=hi; asm volatile("":"+v"(hi2)); const int kb=64*t+4*hi2;
  #pragma unroll
  for(int r=0;r<16;++r){const int kv=kb+(r&3)+8*(r>>2); const int rel=rq-kv;
    int i0=rel<-1?-1:rel; i0=i0>128?128:i0; int i1=rel-32<-1?-1:rel-32; i1=i1>128?128:i1;
    p0[r]+=tab[i0+1]; p1[r]+=tab[i1+1];
    if(FIRST){p0[r]=-INFINITY; if(kv+32<48)p1[r]=-INFINITY;}}
}

constexpr int NSLOT=4, SLOTB=8192;
constexpr int LDS_K=0, LDS_V=NSLOT*SLOTB, LDS_WS=3*NSLOT*SLOTB, LDS_OST=LDS_WS+NW*64*4, LDS_TAB=LDS_OST+NW*4096, LDS_TB4=LDS_TAB+8*132*4, LDS_BYTES=LDS_TB4+4*TB4N*4;
__device__ __forceinline__ void glds16(const void*gsrc,unsigned lds_dst){unsigned keep;
  asm volatile("s_mov_b32 %0, m0\n\ts_mov_b32 m0, %2\n\ts_nop 0\n\tglobal_load_lds_dwordx4 %1, off\n\ts_mov_b32 m0, %0":"=&s"(keep):"v"(gsrc),"s"(lds_dst):"memory");}
__device__ __forceinline__ float max3f(float a,float b,float c){float r;asm("v_max3_f32 %0, %1, %2, %3":"=v"(r):"v"(a),"v"(b),"v"(c));return r;}
__device__ __forceinline__ float max2f(float a,float b){float r;asm("v_max_f32_e32 %0, %1, %2":"=v"(r):"v"(a),"v"(b));return r;}
__device__ __forceinline__ float fadd_s(float a,float b){float r;asm("v_add_f32_e32 %0, %1, %2":"=v"(r):"v"(a),"v"(b));return r;}
__device__ __forceinline__ float fsub_s(float a,float b){float r;asm("v_sub_f32_e32 %0, %1, %2":"=v"(r):"v"(a),"v"(b));return r;}
typedef float f32x2_t __attribute__((ext_vector_type(2))); typedef __bf16 bf16x2_t __attribute__((ext_vector_type(2)));
__device__ __forceinline__ unsigned cvtpk_s(float lo,float hi){f32x2_t v={lo,hi};bf16x2_t b=__builtin_convertvector(v,bf16x2_t);return __builtin_bit_cast(unsigned,b);}
#define WAIT_BAR(N) asm volatile("s_waitcnt vmcnt(" #N ") lgkmcnt(0)\n\ts_barrier":::"memory")

__device__ __forceinline__ void qkt(f32x16&p0,f32x16&p1,const char*Kslot,const bf16x8*qr,const f32x16&negm,int r32,int hi){
  const char*kb=Kslot+hi*1024+r32*16;
  #pragma unroll
  for(int d0=0;d0<4;++d0){
    const bf16x8 b0=*reinterpret_cast<const bf16x8*>(kb+d0*2048);
    const bf16x8 b1=*reinterpret_cast<const bf16x8*>(kb+d0*2048+512);
    if(d0==0){p0=__builtin_amdgcn_mfma_f32_32x32x16_bf16(b0,qr[0],negm,0,0,0);p1=__builtin_amdgcn_mfma_f32_32x32x16_bf16(b1,qr[0],negm,0,0,0);}
    else{p0=__builtin_amdgcn_mfma_f32_32x32x16_bf16(b0,qr[d0],p0,0,0,0);p1=__builtin_amdgcn_mfma_f32_32x32x16_bf16(b1,qr[d0],p1,0,0,0);}}
}
typedef __attribute__((address_space(3))) const char* lds_cptr;
typedef short v4i16_t __attribute__((ext_vector_type(4)));
__device__ __forceinline__ void kload8(bf16x8*kf,lds_cptr kp){
  kf[0]=*(const __attribute__((address_space(3))) bf16x8*)(kp);      kf[1]=*(const __attribute__((address_space(3))) bf16x8*)(kp+512);
  kf[2]=*(const __attribute__((address_space(3))) bf16x8*)(kp+2048); kf[3]=*(const __attribute__((address_space(3))) bf16x8*)(kp+2560);
  kf[4]=*(const __attribute__((address_space(3))) bf16x8*)(kp+4096); kf[5]=*(const __attribute__((address_space(3))) bf16x8*)(kp+4608);
  kf[6]=*(const __attribute__((address_space(3))) bf16x8*)(kp+6144); kf[7]=*(const __attribute__((address_space(3))) bf16x8*)(kp+6656);
}
__device__ __forceinline__ void kload2(bf16x8*kf,lds_cptr kp,int j){ kf[2*j]=*(const __attribute__((address_space(3))) bf16x8*)(kp+j*2048); kf[2*j+1]=*(const __attribute__((address_space(3))) bf16x8*)(kp+j*2048+512); }
__device__ __forceinline__ s16x4 vtr(lds_cptr p){ return __builtin_bit_cast(s16x4,__builtin_amdgcn_ds_read_tr16_b64_v4i16((__attribute__((address_space(3))) v4i16_t*)p)); }
__device__ __forceinline__ float rowmax(const f32x16&p0,const f32x16&p1){
  float a=max3f(p0[0],p0[1],p1[0]),b=max3f(p0[2],p0[3],p1[1]);a=max3f(a,p1[2],p1[3]);
  #pragma unroll
  for(int r=4;r<16;r+=4){a=max3f(a,p0[r],p0[r+1]);b=max3f(b,p0[r+2],p0[r+3]);a=max3f(a,p1[r],p1[r+1]);b=max3f(b,p1[r+2],p1[r+3]);}
  const float m=max2f(a,b);
  auto rr=__builtin_amdgcn_permlane32_swap(__float_as_uint(m),__float_as_uint(m),false,false);
  return max2f(__uint_as_float(rr[0]),__uint_as_float(rr[1]));
}
__device__ __forceinline__ void pv(f32x16*o,int vb,bf16x8 pa0,bf16x8 pa1,bf16x8 pa2,bf16x8 pa3){
  #pragma unroll
  for(int d0=0;d0<4;++d0){s16x4 lo[4],hi[4];
    #pragma unroll
    for(int ks=0;ks<4;++ks){
      asm volatile("ds_read_b64_tr_b16 %0,%1 offset:%c2":"=&v"(lo[ks]):"v"(vb),"i"(d0*4096+ks*1024):"memory");
      asm volatile("ds_read_b64_tr_b16 %0,%1 offset:%c2":"=&v"(hi[ks]):"v"(vb),"i"(d0*4096+ks*1024+512):"memory");}
    asm volatile("s_waitcnt lgkmcnt(0)":::"memory");SBAR();
    #define PK(k) (bf16x8){lo[k][0],lo[k][1],lo[k][2],lo[k][3],hi[k][0],hi[k][1],hi[k][2],hi[k][3]}
    o[d0]=__builtin_amdgcn_mfma_f32_32x32x16_bf16(pa0,PK(0),o[d0],0,0,0);
    o[d0]=__builtin_amdgcn_mfma_f32_32x32x16_bf16(pa1,PK(1),o[d0],0,0,0);
    o[d0]=__builtin_amdgcn_mfma_f32_32x32x16_bf16(pa2,PK(2),o[d0],0,0,0);
    o[d0]=__builtin_amdgcn_mfma_f32_32x32x16_bf16(pa3,PK(3),o[d0],0,0,0);
    #undef PK
  }
}

#ifndef ATTN_STORE16
#define ATTN_STORE16(p,v) (*(u32x4*)(p)=(v))
#endif
template<int THRL> __device__ __forceinline__ void attn_unit(int b,int hq,int hvc,int hoc,int qb,const bf16*Q,const bf16*__restrict__ K,const bf16*__restrict__ V,bf16*O,char*shm,bool comb,bf16*MIXO,float lam,const float*sg,bool newhead){
  const int tid=threadIdx.x,lane=tid&63,r32=lane&31,hi=lane>>5; const int wid=__builtin_amdgcn_readfirstlane(tid>>6);
  const long rowbase=(long)b*mk::TP; const int q0=mk::TPAD+qb*QB;
  const bf16*Qw=Q+(rowbase+q0+wid*QBLK)*DM+hq*D;
  const bf16*Kh=K+rowbase*DM+hq*D,*Vh=V+rowbase*DM+hvc;
  const unsigned lds0=(unsigned)(uintptr_t)shm;
  float*wsf=(float*)(shm+LDS_WS)+wid*64;
  const bf16*ksrc=Kh+(long)lane*DM+wid*8;
  const bf16*vsrc=Vh+(long)(16*(wid&3)+(lane>>2))*DM+(wid>>2)*32+(lane&3)*8;
  const unsigned kdst=lds0+LDS_K+wid*1024, vdst=lds0+LDS_V+wid*1024;
  const __amdgpu_buffer_rsrc_t rK=__builtin_amdgcn_make_buffer_rsrc((void*)K,0,0x7fffffff,0x00020000), rV=__builtin_amdgcn_make_buffer_rsrc((void*)V,0,0x7fffffff,0x00020000);
  const int kvo=(int)(((long)lane*DM+wid*8)*2), vvo=(int)(((long)(16*(wid&3)+(lane>>2))*DM+(wid>>2)*32+(lane&3)*8)*2);
  const int kso=(int)((rowbase*DM+hq*D)*2), vso=(int)((rowbase*DM+hvc)*2);
  typedef __attribute__((address_space(3))) void* lds_vptr; const __attribute__((address_space(3))) char* shl=(const __attribute__((address_space(3))) char*)shm;
  #define DMA_K(t,slot) __builtin_amdgcn_raw_ptr_buffer_load_lds(rK,(lds_vptr)(shl+LDS_K+wid*1024+(slot)),16,kvo,kso+(t)*(KVBLK*DM*2),0,0)
  #define DMA_V(t,slot) do{ __builtin_amdgcn_raw_ptr_buffer_load_lds(rV,(lds_vptr)(shl+LDS_V+wid*1024+2*(slot)),16,vvo,vso+(t)*(KVBLK*DM*2),0,0); __builtin_amdgcn_raw_ptr_buffer_load_lds(rV,(lds_vptr)(shl+LDS_V+wid*1024+2*(slot)+8192),16,vvo,vso+(t)*(KVBLK*DM*2)+128,0,0); }while(0)
  const int vb0=(int)(lds0+LDS_V)+((lane>>4)&1)*32+(lane&3)*8+(4*hi+((lane&15)>>2))*64;
  const char*Kbase=shm+LDS_K; bf16x8 kf[8];
  const lds_cptr shm3=(lds_cptr)shm; const lds_cptr kp0=shm3+LDS_K+hi*1024+r32*16; const lds_cptr vp0=shm3+LDS_V+((lane>>4)&1)*32+(lane&3)*8+(4*hi+((lane&15)>>2))*64;
  const int NT=(q0+QB)/KVBLK;
  const lds_fptr tabl=(lds_fptr)((__attribute__((address_space(3))) const char*)shm+LDS_TAB)+(hq>>1)*132;
  DMA_K(0,0);DMA_V(0,0);DMA_K(1,SLOTB);
  if(newhead){ __attribute__((address_space(3))) float* t4=(__attribute__((address_space(3))) float*)((__attribute__((address_space(3))) char*)shm+LDS_TB4);
    for(int idx=tid;idx<4*TB4N;idx+=NW*64){ const int s_=idx/TB4N, i_=idx-s_*TB4N, rel_=TB4R-(i_+s_);
      t4[idx]= rel_<0 ? -INFINITY : tabl[(rel_>128?128:rel_)+1]; } }
  const __attribute__((address_space(3))) char* tb4=(const __attribute__((address_space(3))) char*)shm+LDS_TB4;
  bf16x8 qr[4];
  #pragma unroll
  for(int d0=0;d0<4;++d0)qr[d0]=*reinterpret_cast<const bf16x8*>(&Qw[(long)r32*DM+d0*16+hi*8]);
  #define QF(d0) qr[d0]
  float mhat=0.f,l_reg=0.f;f32x16 o[4];o[0]=f32x16{};o[1]=f32x16{};o[2]=f32x16{};o[3]=f32x16{};const f32x16 zero16=f32x16{};
  typedef short s16x4_ __attribute__((ext_vector_type(4)));
  s16x4_ kx=(s16x4_){(short)(hi==0?0x3F80:0),0,0,0}, qx=(s16x4_){0,0,0,0};
  #define BFR(x) __builtin_bit_cast(float,(mk::f2bf(x))<<16)
  #define SETQX() do{ qx[0]=(short)(hi==0?(mk::f2bf(-mhat)):0u); asm volatile("":"+v"(qx)); }while(0)
  #define MFX() __builtin_amdgcn_mfma_f32_32x32x8bf16_1k(kx,qx,zero16,0,0,0)
  const int rq=q0+wid*QBLK+r32;
  #define CMASK(P0,P1,t) biasmask4<true>(P0,P1,0,rq,hi,tb4)
  bool resc=false;
  #define START(P0,P1) do{ const float rm=rowmax(P0,P1); resc=false; mhat=BFR(rm); SETQX(); \
    _Pragma("unroll") for(int r=0;r<16;++r)P0[r]=__builtin_amdgcn_exp2f(fsub_s(P0[r],mhat)); }while(0)
  #define RESC() do{ if(resc){ asm volatile("s_waitcnt lgkmcnt(0)":::"memory"); \
      _Pragma("unroll") for(int d_=0;d_<4;++d_) _Pragma("unroll") for(int r=0;r<16;++r)o[d_][r]*=wsf[crow(r,hi)]; } }while(0)
  f32x16 pA0,pA1,pB0,pB1;
  int sl_prev=0,sl_cur=0,sl_next=SLOTB;
  #define ROT() do{sl_prev=sl_cur;sl_cur=sl_next;sl_next=(sl_next==(NSLOT-1)*SLOTB)?0:sl_next+SLOTB;}while(0)
  DMA_K(2,2*SLOTB);
  WAIT_BAR(4);
  qkt(pA0,pA1,Kbase,qr,zero16,r32,hi);asm volatile("s_nop 15\n\ts_nop 7":"+v"(pA0),"+v"(pA1));CMASK(pA0,pA1,0);
  START(pA0,pA1);
  _Pragma("unroll") for(int r=0;r<16;++r)pA1[r]=__builtin_amdgcn_exp2f(fsub_s(pA1[r],mhat));
  WAIT_BAR(0);
  DMA_K(3,3*SLOTB);DMA_V(1,SLOTB);
  ROT();
  kload8(kf,kp0+sl_cur);
  WAIT_BAR(3);
  s16x4 vlo[16],vhi[16]; u32x4 pw0,pw1,pw2,pw3;
  #define PKW(P,B) cvtpk_s(P[B],P[B+1])
  #define PAF(k) __builtin_bit_cast(bf16x8,pw##k)
  #define VFR(i) (bf16x8){vlo[i][0],vlo[i][1],vlo[i][2],vlo[i][3],vhi[i][0],vhi[i][1],vhi[i][2],vhi[i][3]}
  #define PIN(x) asm volatile("":"+v"(x))
  #define MX3(a,b,c) __builtin_fmaxf(__builtin_fmaxf((a),(b)),(c))
  #define GAPA(MF,A0,A1,A2,A3,W0,W1,PW) do{ MF; sacc+=A0; sacb+=A1; sacc+=A2; sacb+=A3; PIN(sacc); PIN(sacb); W0; W1; PIN(PW); SBAR(); }while(0)
  #define EX(v) __builtin_amdgcn_exp2f(v)
  #define GAPB(MF,X,B) do{ MF; X[B]=EX(X[B]); X[B+1]=EX(X[B+1]); PIN(X); SBAR(); }while(0)
  #define VRD(i) do{ vlo[i]=vtr(vp_+(((i)>>2)*4096+((i)&3)*1024)); vhi[i]=vtr(vp_+(((i)>>2)*4096+((i)&3)*1024+512)); }while(0)
  #define KRD(G,j) do{ if(G){ kload2(kf,kp0+sl_next,j); SBAR(); } }while(0)
  #define MFM(a_,b_,c_) __builtin_amdgcn_mfma_f32_32x32x16_bf16(a_,b_,c_,0,0,0)
  #define HALFA(C0,C1,P0,P1,t,GK,GV,DM) do{ SBAR(); \
    const lds_cptr vp_=vp0+2*sl_prev; \
    VRD(0); qb_=QF(1); SBAR(); float sacc=P0[0], sacb=P0[1]; \
    GAPA(C0=MFM(kf[0],qa_,MFX()), P0[2],P0[3],P0[4],P0[5],     pw0[0]=PKW(P0,0), pw0[1]=PKW(P0,2), pw0); \
    VRD(4); SBAR(); GAPA(C1=MFM(kf[1],qa_,MFX()), P0[6],P0[7],P0[8],P0[9],     pw0[2]=PKW(P0,4), pw0[3]=PKW(P0,6), pw0); \
    VRD(8); qa_=QF(2); SBAR(); GAPA(C0=MFM(kf[2],qb_,C0),   P0[10],P0[11],P0[12],P0[13], pw1[0]=PKW(P0,8), pw1[1]=PKW(P0,10), pw1); \
    VRD(12);SBAR(); GAPA(C1=MFM(kf[3],qb_,C1),   P0[14],P0[15],P1[0],P1[1],   pw1[2]=PKW(P0,12),pw1[3]=PKW(P0,14), pw1); \
    VRD(1); qb_=QF(3); SBAR(); GAPA(C0=MFM(kf[4],qa_,C0),   P1[2],P1[3],P1[4],P1[5],     pw2[0]=PKW(P1,0), pw2[1]=PKW(P1,2), pw2); \
    VRD(5); SBAR(); GAPA(C1=MFM(kf[5],qa_,C1),   P1[6],P1[7],P1[8],P1[9],     pw2[2]=PKW(P1,4), pw2[3]=PKW(P1,6), pw2); \
    VRD(9); qa_=QF(0); SBAR(); GAPA(C0=MFM(kf[6],qb_,C0),   P1[10],P1[11],P1[12],P1[13], pw3[0]=PKW(P1,8), pw3[1]=PKW(P1,10), pw3); \
    VRD(13);SBAR(); GAPA(C1=MFM(kf[7],qb_,C1),   P1[14],P1[15],0.f,0.f,       pw3[2]=PKW(P1,12),pw3[3]=PKW(P1,14), pw3); \
    l_reg+=sacc+sacb; \
    if(DM){ if(GK){DMA_K((t)+3,sl_prev);} if(GV){DMA_V((t)+1,sl_next);} } \
    CMASK(C0,C1,t); \
    { float a=MX3(C0[0],C0[1],C1[0]),b=MX3(C0[2],C0[3],C1[1]); a=MX3(a,C1[2],C1[3]); \
      _Pragma("unroll") for(int r=4;r<16;r+=4){a=MX3(a,C0[r],C0[r+1]);b=MX3(b,C0[r+2],C0[r+3]);a=MX3(a,C1[r],C1[r+1]);b=MX3(b,C1[r+2],C1[r+3]);} \
      float rm=__builtin_fmaxf(a,b); { auto rr=__builtin_amdgcn_permlane32_swap(__float_as_uint(rm),__float_as_uint(rm),false,false); rm=__builtin_fmaxf(__uint_as_float(rr[0]),__uint_as_float(rr[1])); } \
      resc=false; const float dm=rm;                   \
      if(__builtin_expect(__any(dm>(float)THRL),0)){ const float mn=BFR(mhat+__builtin_fmaxf(dm,0.f)); const float dl=mn-mhat; mhat=mn; SETQX(); \
        _Pragma("unroll") for(int r=0;r<16;++r){ C0[r]-=dl; C1[r]-=dl; }          \
        const float f=__builtin_amdgcn_exp2f(-dl); l_reg*=f; if(hi==0)wsf[r32]=f; resc=true; } } \
    SBAR(); \
    }while(0)
  #define HALFB(C0,C1,P0,P1,t,GK,GV,GL,DM) do{ \
    const lds_cptr vp_=vp0+2*sl_prev; \
    if(DM){ if(GK){DMA_K((t)+3,sl_prev);} if(GV){DMA_V((t)+1,sl_next);} } \
      \
    VRD(2); SBAR(); GAPB(o[0]=MFM(PAF(0),VFR(0),o[0]),  C0,0); \
    VRD(6); SBAR(); GAPB(o[1]=MFM(PAF(0),VFR(4),o[1]),  C0,2); \
    VRD(10);SBAR(); GAPB(o[2]=MFM(PAF(0),VFR(8),o[2]),  C0,4); \
    VRD(14);SBAR(); GAPB(o[3]=MFM(PAF(0),VFR(12),o[3]), C0,6); \
    VRD(3); SBAR(); GAPB(o[0]=MFM(PAF(1),VFR(1),o[0]),  C0,8); \
    VRD(7); SBAR(); GAPB(o[1]=MFM(PAF(1),VFR(5),o[1]),  C0,10); \
    VRD(11);SBAR(); GAPB(o[2]=MFM(PAF(1),VFR(9),o[2]),  C0,12); \
    VRD(15);SBAR(); GAPB(o[3]=MFM(PAF(1),VFR(13),o[3]), C0,14); \
    KRD(GL,0); GAPB(o[0]=MFM(PAF(2),VFR(2),o[0]),  C1,0); \
    KRD(GL,1); GAPB(o[1]=MFM(PAF(2),VFR(6),o[1]),  C1,2); \
    KRD(GL,2); GAPB(o[2]=MFM(PAF(2),VFR(10),o[2]), C1,4); \
    KRD(GL,3); GAPB(o[3]=MFM(PAF(2),VFR(14),o[3]), C1,6); \
    GAPB(o[0]=MFM(PAF(3),VFR(3),o[0]),  C1,8); \
    GAPB(o[1]=MFM(PAF(3),VFR(7),o[1]),  C1,10); \
    GAPB(o[2]=MFM(PAF(3),VFR(11),o[2]), C1,12); \
    GAPB(o[3]=MFM(PAF(3),VFR(15),o[3]), C1,14); \
    }while(0)
  #define STEP(C0,C1,P0,P1,t,GK,GV,GL) do{ HALFA(C0,C1,P0,P1,t,GK,GV,true); HALFB(C0,C1,P0,P1,t,GK,GV,GL,false); }while(0)
  bf16x8 qa_=QF(0),qb_;
  int t=1;
  #undef CMASK
  #define CMASK(P0,P1,t) do{}while(0)
  if(wid>=4){ WAIT_BAR(3); }
  for(;t+8<=NT;t+=2){
      HALFA(pB0,pB1,pA0,pA1,t,true,true,true);        WAIT_BAR(3);
      HALFB(pB0,pB1,pA0,pA1,t,true,true,true,false);  WAIT_BAR(3); RESC(); ROT();
      HALFA(pA0,pA1,pB0,pB1,t+1,true,true,true);      WAIT_BAR(3);
      HALFB(pA0,pA1,pB0,pB1,t+1,true,true,true,false);WAIT_BAR(3); RESC(); ROT();
  }
  if(wid<4){ WAIT_BAR(3); }
  #undef CMASK
  #define CMASK(P0,P1,t) biasmask4<false>(P0,P1,(t),rq,hi,tb4)
  #define ENDW(tt) do{ if((tt)+3<NT){WAIT_BAR(3);} else if((tt)+2<NT){WAIT_BAR(2);} else {WAIT_BAR(0);} }while(0)
  for(;t+2<NT;t+=2){
    STEP(pB0,pB1,pA0,pA1,t,(t+3<NT),(t+1<NT),(t+1<NT));       ENDW(t);   RESC(); ROT();
    STEP(pA0,pA1,pB0,pB1,t+1,(t+4<NT),(t+2<NT),(t+2<NT));     ENDW(t+1); RESC(); ROT();
  }
  STEP(pB0,pB1,pA0,pA1,t,false,true,true);      WAIT_BAR(0); RESC(); ROT();
  STEP(pA0,pA1,pB0,pB1,t+1,false,false,false);  RESC();
  { float sacc=pA0[0]+pA0[1]; _Pragma("unroll") for(int r=2;r<16;++r)sacc+=pA0[r]; _Pragma("unroll") for(int r=0;r<16;++r)sacc+=pA1[r]; l_reg+=sacc;
    pw0=(u32x4){PKW(pA0,0),PKW(pA0,2),PKW(pA0,4),PKW(pA0,6)};pw1=(u32x4){PKW(pA0,8),PKW(pA0,10),PKW(pA0,12),PKW(pA0,14)};pw2=(u32x4){PKW(pA1,0),PKW(pA1,2),PKW(pA1,4),PKW(pA1,6)};pw3=(u32x4){PKW(pA1,8),PKW(pA1,10),PKW(pA1,12),PKW(pA1,14)};
    SBAR(); pv(o,vb0+2*sl_cur,PAF(0),PAF(1),PAF(2),PAF(3)); }
  #undef PKW
  #undef PAF
  #undef VFR
  #undef PIN
  #undef MX3
  #undef GAPA
  #undef GAPB
  #undef EX
  #undef VRD
  #undef KRD
  #undef STEP
  #undef HALFA
  #undef HALFB
  #undef MFM
  #undef QF
  #undef ENDW
  {auto rr=__builtin_amdgcn_permlane32_swap(__float_as_uint(l_reg),__float_as_uint(l_reg),false,false);l_reg=__uint_as_float(rr[0])+__uint_as_float(rr[1]);}
  if(hi==0)wsf[32+r32]=l_reg;asm volatile("s_waitcnt lgkmcnt(0)":::"memory");
  float rli[16];
  #pragma unroll
  for(int r=0;r<16;++r)rli[r]=__builtin_amdgcn_rcpf(wsf[32+crow(r,hi)]);
  bf16*Ow=O+((long)b*mk::SEQ+qb*QB+wid*QBLK)*OP+hoc;
  int lane_e=lane; asm volatile("":"+v"(lane_e));
  const int r32e=lane_e&31, hie=lane_e>>5;
  { bf16*stg=(bf16*)(shm+LDS_OST)+wid*2048;
    float oh[2][4][8]; float ssr[4]={0.f,0.f,0.f,0.f};
    u32x4 zz[2][4];
    float sgl[16];
    if(comb){
      #pragma unroll
      for(int hh=0;hh<2;++hh)
        #pragma unroll
        for(int q=0;q<8;++q)sgl[hh*8+q]=sg[hh*64+(lane_e&7)*8+q]*0.8f;
      #pragma unroll
      for(int hh=0;hh<2;++hh)
        #pragma unroll
        for(int i=0;i<4;++i)zz[hh][i]=*(const u32x4*)(Ow+(long)(i*8+(lane_e>>3))*OP+hh*64+(lane_e&7)*8); }
    #pragma unroll
    for(int hh=0;hh<2;++hh){
      #pragma unroll
      for(int r=0;r<16;++r){const int orow=crow(r,hie);
        #pragma unroll
        for(int d0=0;d0<2;++d0)stg[orow*64+d0*32+r32e]=__float2bfloat16(o[2*hh+d0][r]*rli[r]);}
      asm volatile("s_waitcnt lgkmcnt(0)":::"memory");
      #pragma unroll
      for(int i=0;i<4;++i){const int row=i*8+(lane_e>>3),ch=lane_e&7; const u32x4 v=*(const u32x4*)(stg+row*64+ch*8);
        if(!comb){ ATTN_STORE16(Ow+(long)row*OP+hh*64+ch*8,v); }
        else{ const u32x4 z=zz[hh][i]; const unsigned zw[4]={z.x,z.y,z.z,z.w},vw[4]={v.x,v.y,v.z,v.w};
          #pragma unroll
          for(int q=0;q<4;++q){ const float a0=mk::bflo(zw[q])-lam*mk::bflo(vw[q]),a1=mk::bfhi(zw[q])-lam*mk::bfhi(vw[q]); oh[hh][i][2*q]=a0; oh[hh][i][2*q+1]=a1; ssr[i]+=a0*a0+a1*a1; } } }
      asm volatile("s_waitcnt lgkmcnt(0)":::"memory");
    }
    if(comb){ const int ch=lane_e&7;
      bf16*Mw=MIXO+((long)b*mk::SEQ+qb*QB+wid*QBLK)*2048+hoc;
      #pragma unroll
      for(int i=0;i<4;++i){ float ss=ssr[i]; ss+=__shfl_xor(ss,1); ss+=__shfl_xor(ss,2); ss+=__shfl_xor(ss,4);
        const float rs=1.0f/sqrtf(ss*(1.f/128.f)+mk::EPS); const int row=i*8+(lane_e>>3);
        #pragma unroll
        for(int hh=0;hh<2;++hh){ u32x4 w;
          w.x=mk::pk2(oh[hh][i][0]*rs*sgl[hh*8+0],oh[hh][i][1]*rs*sgl[hh*8+1]); w.y=mk::pk2(oh[hh][i][2]*rs*sgl[hh*8+2],oh[hh][i][3]*rs*sgl[hh*8+3]);
          w.z=mk::pk2(oh[hh][i][4]*rs*sgl[hh*8+4],oh[hh][i][5]*rs*sgl[hh*8+5]); w.w=mk::pk2(oh[hh][i][6]*rs*sgl[hh*8+6],oh[hh][i][7]*rs*sgl[hh*8+7]);
          *(u32x4*)(Mw+(long)row*2048+hh*64+ch*8)=w; } } }
  }
  asm volatile("s_waitcnt lgkmcnt(0)\n\ts_barrier":::"memory");
  #undef DMA_K
  #undef DMA_V
  #undef CMASK
  #undef START
  #undef RESC
  #undef ROT
}
constexpr int ATTN_LDS_BYTES=LDS_BYTES;
__device__ __forceinline__ void attn_load_tab(const float*biastab,char*shm){ __attribute__((address_space(3))) float*tw=(__attribute__((address_space(3))) float*)((__attribute__((address_space(3))) char*)shm+LDS_TAB); for(int i=threadIdx.x;i<8*132;i+=512)tw[i]=biastab[i]; }
#undef SBAR
#undef WAIT_BAR
}
namespace mk {
__device__ __forceinline__ float sigmoid_f(float x) { return __builtin_amdgcn_rcpf(1.0f + __expf(-x)); }
__device__ __forceinline__ float gelu_tanh_f(float x) { constexpr float c1 = -1.5957691216057308f * LOG2E; const float u = __builtin_fmaf(x * x, 0.044715f * c1, c1); return x * __builtin_amdgcn_rcpf(1.0f + __builtin_amdgcn_exp2f(x * u)); }
__device__ __forceinline__ bf16x8 pack8(const float (&v)[8]) { u32x4 w; w.x = cvt_pk_bf16(v[0], v[1]); w.y = cvt_pk_bf16(v[2], v[3]); w.z = cvt_pk_bf16(v[4], v[5]); w.w = cvt_pk_bf16(v[6], v[7]); return __builtin_bit_cast(bf16x8, w); }

template <int MODE>
__device__ __forceinline__ void lru_item(const Args& a, LAS unsigned char* wl, int b, int c, int blk, int lane) {
    unsigned char* ws = a.ws;
    const bf16_t* XL = (const bf16_t*)(ws + WS_PROJ + 3 * PROJ_TSTRIDE); const bf16_t* GL = (const bf16_t*)(ws + WS_PROJ + 4 * PROJ_TSTRIDE);
    f32x2* TOT = (f32x2*)(ws + WS_SMALL + SM_LRUTOT);
    bf16_t* MIX = (bf16_t*)(ws + WS_MIX);
    const int c0 = blk * 64, ch = c0 + lane, fr = lane & 15, g = lane >> 4;
    LAS float* XC = (LAS float*)wl; LAS float* AA = XC + 16 * 68; LAS float* BX = AA + 16 * 65;
    const u32x4* LW = (const u32x4*)(ws + WS_SMALL + SM_LRUW) + (size_t)blk * 1024 + lane; const float* LC = (const float*)(ws + WS_SMALL + SM_LRUC);
    bf16x8 wrf[4][2], wif[4][2];
#pragma unroll
    for (int nt = 0; nt < 4; ++nt)
#pragma unroll
        for (int kk = 0; kk < 2; ++kk) { wrf[nt][kk] = __builtin_bit_cast(bf16x8, LW[(nt * 2 + kk) * 64]); wif[nt][kk] = __builtin_bit_cast(bf16x8, LW[512 + (nt * 2 + kk) * 64]); }
    float br[4], bi[4], ls8[4];
#pragma unroll
    for (int nt = 0; nt < 4; ++nt) { const int cc = c0 + 16 * nt + fr; br[nt] = LC[cc]; bi[nt] = LC[1024 + cc]; ls8[nt] = LC[2048 + cc]; }
    const float cw0 = a.in[I_CONVW][ch], cw1 = a.in[I_CONVW][1024 + ch], cw2 = a.in[I_CONVW][2048 + ch], cw3 = a.in[I_CONVW][3072 + ch], cb = a.in[I_CONVB][ch];
    const int rb = b * TP; const int r0 = rb + (c == 0 ? 48 : 64 + LCH * c); const int nsub = (c == 0) ? 9 : 8;
    float xm3 = bf2f(XL[(size_t)(r0 - 3) * 1024 + ch]), xm2 = bf2f(XL[(size_t)(r0 - 2) * 1024 + ch]), xm1 = bf2f(XL[(size_t)(r0 - 1) * 1024 + ch]);
    float h = 0.f, acum = 1.f;
    if (MODE == 1 && c > 0) {
        f32x2 ta[16], tb[16];
        const f32x2* tp = TOT + (size_t)b * NCH * 1024 + ch;
#define LRU_TLOAD(T_, j0_) do { _Pragma("unroll") for (int q = 0; q < 16; ++q) { const int jj = (j0_) + q < c ? (j0_) + q : c - 1; T_[q] = tp[(size_t)jj * 1024]; } } while (0)
#define LRU_TFOLD(T_, j0_) do { _Pragma("unroll") for (int q = 0; q < 16; ++q) { const bool on = (j0_) + q < c; const float A = on ? T_[q].x : 1.f, H = on ? T_[q].y : 0.f; h = A * h + H; } } while (0)
        LRU_TLOAD(ta, 0);
        for (int j = 0; j < c; j += 32) { LRU_TLOAD(tb, j + 16); LRU_TFOLD(ta, j); LRU_TLOAD(ta, j + 32); LRU_TFOLD(tb, j + 16); }
#undef LRU_TLOAD
#undef LRU_TFOLD
    }
    unsigned short xn[16], gn[16];
#pragma unroll
    for (int i = 0; i < 16; ++i) { xn[i] = XL[(size_t)(r0 + i) * 1024 + ch]; if (MODE == 1) gn[i] = GL[(size_t)(r0 + i) * 1024 + ch]; }
    for (int sub = 0; sub < nsub; ++sub) {
        const int rs = r0 + 16 * sub;
        float xv[16]; float gv[16];
#pragma unroll
        for (int i = 0; i < 16; ++i) { xv[i] = bf2f(xn[i]); if (MODE == 1) gv[i] = bf2f(gn[i]); }
#pragma unroll
        for (int i = 0; i < 16; ++i) { xn[i] = XL[(size_t)(rs + 16 + i) * 1024 + ch]; if (MODE == 1) gn[i] = GL[(size_t)(rs + 16 + i) * 1024 + ch]; }
#pragma unroll
        for (int i = 0; i < 16; ++i) { const float xc = cb + cw0 * xm3 + cw1 * xm2 + cw2 * xm1 + cw3 * xv[i]; XC[i * 68 + lane] = xc; xm3 = xm2; xm2 = xm1; xm1 = xv[i]; }
        bf16x8 af[2];
#pragma unroll
        for (int kk = 0; kk < 2; ++kk) { const f32x4 p = *(const LAS f32x4*)(XC + fr * 68 + 32 * kk + 8 * g), q = *(const LAS f32x4*)(XC + fr * 68 + 32 * kk + 8 * g + 4);
            const float t[8] = {p.x, p.y, p.z, p.w, q.x, q.y, q.z, q.w}; af[kk] = pack8(t); }
        f32x4 accR[4], accI[4];
#pragma unroll
        for (int nt = 0; nt < 4; ++nt) {
            accR[nt] = __builtin_amdgcn_mfma_f32_16x16x32_bf16(af[0], wrf[nt][0], (f32x4){br[nt], br[nt], br[nt], br[nt]}, 0, 0, 0); accR[nt] = __builtin_amdgcn_mfma_f32_16x16x32_bf16(af[1], wrf[nt][1], accR[nt], 0, 0, 0);
            accI[nt] = __builtin_amdgcn_mfma_f32_16x16x32_bf16(af[0], wif[nt][0], (f32x4){bi[nt], bi[nt], bi[nt], bi[nt]}, 0, 0, 0); accI[nt] = __builtin_amdgcn_mfma_f32_16x16x32_bf16(af[1], wif[nt][1], accI[nt], 0, 0, 0); }
        float xc8[8];
#pragma unroll
        for (int nt = 0; nt < 4; ++nt) {
            float xcv[4];
            if ((nt & 1) == 0) {
#pragma unroll
                for (int q = 0; q < 8; ++q) xc8[q] = XC[(4 * g + (q & 3)) * 68 + 16 * (nt + (q >> 2)) + fr]; }
#pragma unroll
            for (int r = 0; r < 4; ++r) xcv[r] = xc8[4 * (nt & 1) + r];
#pragma unroll
            for (int r = 0; r < 4; ++r) { const int tok = 4 * g + r, cl = 16 * nt + fr;
                const float rg = __builtin_amdgcn_rcpf(1.0f + __builtin_amdgcn_exp2f(accR[nt][r])), ig = __builtin_amdgcn_rcpf(1.0f + __builtin_amdgcn_exp2f(accI[nt][r]));
                const float av = __builtin_amdgcn_exp2f(rg * ls8[nt]);
                const float om = 1.f - av * av;
                const float bxv = __builtin_amdgcn_sqrtf(om) * ig * xcv[r];
                AA[tok * 65 + cl] = av; BX[tok * 65 + cl] = bxv; } }
        float hs[16];
#pragma unroll
        for (int i = 0; i < 16; ++i) { const float av = AA[i * 65 + lane], bv = BX[i * 65 + lane]; h = av * h + bv; acum *= av; hs[i] = h; }
        if (MODE == 1 && rs >= rb + 64) {
#pragma unroll
            for (int i = 0; i < 16; ++i) { const int row = rs + i;
                MIX[((size_t)b * SEQ + (row - rb - 64)) * 2048 + ch] = (bf16_t)cvt_pk_bf16(hs[i] * gelu_tanh_f(gv[i]), 0.f); }
        }
    }
    if (MODE == 0) TOT[(size_t)(b * NCH + c) * 1024 + ch] = (f32x2){acum, h};
}

__device__ __forceinline__ void p2_attn_lru(const Args& a, LAS unsigned char* lds, unsigned char* lds_generic, int vcu, int G, int wave, int lane) {
    unsigned char* ws = a.ws;
    const int gw = vcu * 8 + wave, NGW = G * 8;
    for (int it = gw; it < NB * NCH * NLB; it += NGW) lru_item<0>(a, lds + wave * 16384, it / (NCH * NLB), (it / NLB) % NCH, it % NLB, lane);
    asm volatile("s_waitcnt vmcnt(0)" ::: "memory");
    __syncthreads();
    if (threadIdx.x == 0) { __builtin_amdgcn_fence(__ATOMIC_RELEASE, "agent"); asm volatile("s_waitcnt vmcnt(0)" ::: "memory"); (void)xb_add((unsigned*)(ws + WS_CTL) + CW_LRU1 + 64 * (blockIdx.x & 7), 1u); }
    attn2::attn_load_tab((const float*)(ws + WS_SMALL + SM_BIAS), (char*)lds_generic);
    __syncthreads();
    const attn2::bf16* Q = (const attn2::bf16*)(ws + WS_PROJ); const attn2::bf16* K = (const attn2::bf16*)(ws + WS_PROJ + PROJ_TSTRIDE); const attn2::bf16* V = (const attn2::bf16*)(ws + WS_PROJ + 2 * PROJ_TSTRIDE);
    attn2::bf16* O = (attn2::bf16*)(ws + WS_OALL);
    const float lam = __expf(wave_sum(a.in[I_LQ1][lane] * a.in[I_LK1][lane])) - __expf(wave_sum(a.in[I_LQ2][lane] * a.in[I_LK2][lane])) + 0.2f;
    attn2::bf16* MIXO = (attn2::bf16*)(ws + WS_MIX) + 1024;
    const int NGRP = G / 16;
    for (int grp = vcu >> 4; grp < 16; grp += NGRP) {
        const int b = grp >> 3, h = grp & 7, s = vcu & 15;
        for (int j = 0; j < 4; ++j) { const int qb = (j < 2) ? s : 31 - s, m = j & 1;
            attn2::attn_unit<8>(b, h * 2 + m, h * 128, h * 128, qb, Q, K, V, O, (char*)lds_generic, m == 1, MIXO, lam, a.in[I_SUBLN], j == 0); }
    }
    __syncthreads();
    if (threadIdx.x == 0) { unsigned sp = 0u; unsigned* lc = (unsigned*)(ws + WS_CTL) + CW_LRU1;
        for (;;) { unsigned tot = 0u;
#pragma unroll
            for (int q = 0; q < 8; ++q) tot += xb_ld(lc + 64 * q);
            if (tot >= (unsigned)G) break; __builtin_amdgcn_s_sleep(8); if (++sp > (1u << 20)) break; }
        __builtin_amdgcn_fence(__ATOMIC_ACQUIRE, "agent"); asm volatile("s_waitcnt vmcnt(0)" ::: "memory"); }
    __syncthreads();
    for (int it = gw; it < NB * NCH * NLB; it += NGW) lru_item<1>(a, lds + wave * 16384, it / (NCH * NLB), (it / NLB) % NCH, it % NLB, lane);
}

__device__ __forceinline__ void p3_combine(const Args& a, LAS unsigned char* lds, int vcu, int G, int wave, int lane) {
    unsigned char* ws = a.ws;
    const int gw = vcu * 8 + wave, NGW = G * 8;
    for (int it = gw; it < NB * NCH * NLB; it += NGW) lru_item<1>(a, lds + wave * 16384, it / (NCH * NLB), (it / NLB) % NCH, it % NLB, lane);
}
}
namespace mk {
struct EpiH {
    static constexpr bool PERM = true, SIGNALS = false;
    bf16_t* H; const bf16_t* XN; const float* XRMS; const float* GINV; unsigned char* U2; const float* GFFN;
    __device__ __forceinline__ void prefetch(const pg8::Unit&, int, int, float (&)[8]) const {}
    __device__ __forceinline__ void operator()(const f32x4 (&acc)[2][2][4][2], const pg8::Unit& u, int wr, int wc, int fr_, int fq_, const float (&pre)[8]) const {
        int fr = fr_, fq = fq_; asm volatile("" : "+v"(fr), "+v"(fq));
        const int col0 = u.pn * 256 + wc * 32 + 8 * fq, row0 = u.pm * 256 + wr * 64 + fr;
        const size_t base = (size_t)row0 * 2048 + col0;
        f32x4 gi[4];
        { const GAS f32x4* gp = (const GAS f32x4*)(GINV + col0); gi[0] = gp[0]; gi[1] = gp[1]; gi[2] = gp[32]; gi[3] = gp[33]; }
        f32x4 gf[4];
        { const GAS f32x4* gp = (const GAS f32x4*)(GFFN + col0); gf[0] = gp[0]; gf[1] = gp[1]; gf[2] = gp[32]; gf[3] = gp[33]; }
        auto ld = [&](int c, u32x4 (&x)[2], float& rr) { const int ro = (c >> 2) * 128 + (c & 3) * 16; const GAS u32x4* p = (const GAS u32x4*)(XN + base + (size_t)ro * 2048);
            x[0] = __builtin_nontemporal_load(p); x[1] = __builtin_nontemporal_load(p + 16); rr = XRMS[row0 + ro]; };
        auto fin = [&](int c, const u32x4 (&x)[2], float rr) { const int ai = c >> 2, m = c & 3; bf16_t* rowp = H + base + (size_t)(ai * 128 + m * 16) * 2048;
#pragma unroll
            for (int bj = 0; bj < 2; ++bj) { const u32x4 xw = x[bj]; const f32x4 g0 = gi[2 * bj] * rr, g1 = gi[2 * bj + 1] * rr;
                f32x4 v0 = acc[ai][bj][m][0], v1 = acc[ai][bj][m][1];
                v0[0] += bflo(xw.x) * g0[0]; v0[1] += bfhi(xw.x) * g0[1]; v0[2] += bflo(xw.y) * g0[2]; v0[3] += bfhi(xw.y) * g0[3];
                v1[0] += bflo(xw.z) * g1[0]; v1[1] += bfhi(xw.z) * g1[1]; v1[2] += bflo(xw.w) * g1[2]; v1[3] += bfhi(xw.w) * g1[3];
                u32x4 w; w.x = cvt_pk_bf16(v0[0], v0[1]); w.y = cvt_pk_bf16(v0[2], v0[3]); w.z = cvt_pk_bf16(v1[0], v1[1]); w.w = cvt_pk_bf16(v1[2], v1[3]);
                *(u32x4*)(rowp + bj * 128) = w;
                const f32x4 f0 = gf[2 * bj], f1 = gf[2 * bj + 1];
                u32x2 uw; uw.x = pk4_fp8(bflo(w.x) * f0[0], bfhi(w.x) * f0[1], bflo(w.y) * f0[2], bfhi(w.y) * f0[3]); uw.y = pk4_fp8(bflo(w.z) * f1[0], bfhi(w.z) * f1[1], bflo(w.w) * f1[2], bfhi(w.w) * f1[3]);
                *(u32x2*)(U2 + base + (size_t)(ai * 128 + m * 16) * 2048 + bj * 128) = uw; } };
        u32x4 x0[2], x1[2], x2[2], x3[2]; float r0, r1, r2, r3;
        ld(0, x0, r0); ld(1, x1, r1); ld(2, x2, r2); ld(3, x3, r3);
        fin(0, x0, r0); ld(4, x0, r0); fin(1, x1, r1); ld(5, x1, r1); fin(2, x2, r2); ld(6, x2, r2); fin(3, x3, r3); ld(7, x3, r3);
        fin(4, x0, r0); fin(5, x1, r1); fin(6, x2, r2); fin(7, x3, r3);
    }
};
}
namespace mk {
__device__ __forceinline__ void p5_router(const Args& a, LAS unsigned char* lds, int vcu, int G, int wave, int lane) {
    unsigned char* ws = a.ws;
    const bf16_t* HB = (const bf16_t*)(ws + WS_H);
    const bf16_t* WH = (const bf16_t*)(ws + WS_SMALL + SM_WG36);
    gu32* cnt = (gu32*)(ws + WS_CTL) + CW_CNT;
    int* PERM = (int*)(ws + WS_SMALL + SM_PERM); float* RSTD = (float*)(ws + WS_SMALL + SM_RSTD); float* GATE = (float*)(ws + WS_SMALL + SM_GATE);
    int* TOKE = (int*)(ws + WS_SMALL + SM_TOKE); int* TOKS = (int*)(ws + WS_SMALL + SM_TOKS);
    const int tid = threadIdx.x, fr = lane & 15, g = lane >> 4, w4 = wave & 3, kh = wave >> 2;
    constexpr int WROW = 264, WBUF = 2 * 48 * WROW * 2;
    LAS float* XP = (LAS float*)(lds + 2 * WBUF + 8192) + w4 * 832;
#define P5_WLOAD(dst, s_) do { _Pragma("unroll") for (int j_ = 0; j_ < 6; ++j_) { const int id_ = tid + 512 * j_; dst[j_] = *(const GAS u32x4*)(WH + (size_t)(id_ >> 5) * 2048 + 256 * (s_) + 8 * (id_ & 31)); } } while (0)
#define P5_WSTORE(src, buf_) do { _Pragma("unroll") for (int j_ = 0; j_ < 6; ++j_) { const int id_ = tid + 512 * j_; *(LAS u32x4*)(lds + (buf_) * WBUF + ((id_ >> 5) * WROW + 8 * (id_ & 31)) * 2) = src[j_]; } } while (0)
    LAS int* CL = (LAS int*)(lds + 2 * WBUF + 8192 + 4 * 832 * 4);
    for (int tb = vcu; tb < M / 64; tb += G) {
        if (tid < 64) CL[tid] = 0;
        const int m0 = tb * 64 + w4 * 16;
        const size_t rowoff = (size_t)(m0 + fr) * 2048 + 128 * kh + 8 * g;
        { u32x4 w0[6]; P5_WLOAD(w0, 0); P5_WSTORE(w0, 0); }
        u32x4 dA[4], dB[4];
#define P5_XLOAD(dst, kk, s_) do { dst[kk] = __builtin_nontemporal_load((const GAS u32x4*)(HB + rowoff + 256 * (s_) + 32 * (kk))); } while (0)
#pragma unroll
        for (int kk = 0; kk < 4; ++kk) { P5_XLOAD(dA, kk, 0); P5_XLOAD(dB, kk, 1); }
        f32x4 acc[3]; acc[0] = acc[1] = acc[2] = (f32x4){0.f, 0.f, 0.f, 0.f}; float ss = 0.f;
        __syncthreads();
#define P5_STAGE(s, dl) do { \
            u32x4 wn[6]; const int sn = (s) < 7 ? (s) + 1 : 7, s2 = (s) < 6 ? (s) + 2 : 7; \
            P5_WLOAD(wn, sn); \
            const LAS unsigned char* wb = lds + ((s) & 1) * WBUF; \
            _Pragma("unroll") for (int kk = 0; kk < 4; ++kk) { \
                const int kl = 128 * kh + 32 * kk + 8 * g;                             \
                const u32x4 d = dl[kk]; \
                P5_XLOAD(dl, kk, s2); \
                f32x4 p, q; p.x = bflo(d.x); p.y = bfhi(d.x); p.z = bflo(d.y); p.w = bfhi(d.y); q.x = bflo(d.z); q.y = bfhi(d.z); q.z = bflo(d.w); q.w = bfhi(d.w); \
                ss += (p.x * p.x + p.y * p.y) + (p.z * p.z + p.w * p.w) + (q.x * q.x + q.y * q.y) + (q.z * q.z + q.w * q.w); \
                const bf16x8 ah = __builtin_bit_cast(bf16x8, d); \
                _Pragma("unroll") for (int nt = 0; nt < 3; ++nt) { const bf16x8 wh = *(const LAS bf16x8*)(wb + ((16 * nt + fr) * WROW + kl) * 2), wl = *(const LAS bf16x8*)(wb + ((48 + 16 * nt + fr) * WROW + kl) * 2); \
                    acc[nt] = __builtin_amdgcn_mfma_f32_16x16x32_bf16(ah, wh, acc[nt], 0, 0, 0); acc[nt] = __builtin_amdgcn_mfma_f32_16x16x32_bf16(ah, wl, acc[nt], 0, 0, 0); } \
            } \
            P5_WSTORE(wn, ((s) + 1) & 1); \
            __syncthreads(); } while (0)
        for (int s = 0; s < 8; s += 2) { P5_STAGE(s, dA); P5_STAGE(s + 1, dB); }
#undef P5_STAGE
        if (kh == 1) {
#pragma unroll
            for (int nt = 0; nt < 3; ++nt)
#pragma unroll
                for (int r = 0; r < 4; ++r) XP[(nt * 4 + r) * 64 + lane] = acc[nt][r];
            XP[12 * 64 + lane] = ss;
        }
        __syncthreads();
        int tok = 0, ea = 0, eb = 0, ra = 0, rb = 0; float rstd = 0.f, g0 = 0.f, g1 = 0.f; const bool router = (kh == 0) && (lane < 16);
        if (kh == 0) {
            ss += XP[12 * 64 + lane];
#pragma unroll
            for (int nt = 0; nt < 3; ++nt)
#pragma unroll
                for (int r = 0; r < 4; ++r) acc[nt][r] += XP[(nt * 4 + r) * 64 + lane];
            ss += __shfl_xor(ss, 16); ss += __shfl_xor(ss, 32);
            rstd = 1.0f / sqrtf(ss * (1.f / D) + EPS);
            LDS_WAIT(); asm volatile("" ::: "memory");
            LAS float* LG = XP;
#pragma unroll
            for (int nt = 0; nt < 3; ++nt)
#pragma unroll
                for (int r = 0; r < 4; ++r) LG[(4 * g + r) * 49 + 16 * nt + fr] = acc[nt][r];
            LDS_WAIT(); asm volatile("" ::: "memory");
            if (lane < 16) {
                const LAS float* lg = LG + lane * 49; tok = m0 + lane;
                float gl[4]; int grp = 0; float gm = -INFINITY;
#pragma unroll
                for (int j = 0; j < 4; ++j) { gl[j] = lg[j] * rstd + a.in[I_BGRP][j]; if (gl[j] > gm) { gm = gl[j]; grp = j; } }
                float se = 0.f;
#pragma unroll
                for (int j = 0; j < 4; ++j) se += __expf(gl[j] - gm);
                const float pg = 1.f / se;
                float el[8];
#pragma unroll
                for (int j = 0; j < 8; ++j) el[j] = lg[4 + grp * 8 + j] * rstd + a.in[I_BRT][grp * 8 + j];
                int i0 = 0; float v0 = el[0];
#pragma unroll
                for (int j = 1; j < 8; ++j) if (el[j] > v0) { v0 = el[j]; i0 = j; }
                int i1 = -1; float v1 = -INFINITY;
#pragma unroll
                for (int j = 0; j < 8; ++j) if (j != i0 && el[j] > v1) { v1 = el[j]; i1 = j; }
                const float e1 = __expf(v1 - v0); g0 = pg / (1.f + e1); g1 = pg * e1 / (1.f + e1);
                ea = grp * 8 + i0; eb = grp * 8 + i1;
                ra = __hip_atomic_fetch_add(CL + ea, 1, __ATOMIC_RELAXED, __HIP_MEMORY_SCOPE_WORKGROUP); rb = __hip_atomic_fetch_add(CL + eb, 1, __ATOMIC_RELAXED, __HIP_MEMORY_SCOPE_WORKGROUP);
            }
        }
        __syncthreads();
        if (tid < 32) { const int c_ = CL[tid]; CL[32 + tid] = c_ ? (int)__hip_atomic_fetch_add(cnt + tid * CNT_STRIDE, (unsigned)c_, RLX_AGENT) : 0; }
        __syncthreads();
        if (router) {
            const int sa = CL[32 + ea] + ra, sb = CL[32 + eb] + rb;
            PERM[(size_t)ea * ECAP + sa] = tok; PERM[(size_t)eb * ECAP + sb] = tok;
            RSTD[(size_t)ea * ECAP + sa] = rstd; RSTD[(size_t)eb * ECAP + sb] = rstd;
            GATE[tok * 2] = g0; GATE[tok * 2 + 1] = g1;
            TOKE[tok * 2] = ea; TOKE[tok * 2 + 1] = eb; TOKS[tok * 2] = sa; TOKS[tok * 2 + 1] = sb;
        }
        __syncthreads();
    }
#undef P5_WLOAD
#undef P5_WSTORE
#undef P5_XLOAD
}

constexpr int ETAB_OFF = 131072 + 1024;
__device__ __forceinline__ void build_expert_tab(const gu32* cnt, LAS unsigned char* lds, int npn) {
    LAS int* tab = (LAS int*)(lds + ETAB_OFF);
    if (threadIdx.x < 64) { const int lane = threadIdx.x, e = lane & 31;
        const int ce = (int)__hip_atomic_load(cnt + e * CNT_STRIDE, RLX_AGENT); const int te = (ce + 255) >> 8;
        int pu = te * npn, pr = te * 256;
#pragma unroll
        for (int o = 1; o < 32; o <<= 1) { const int qu = __shfl_up(pu, o, 32), qr = __shfl_up(pr, o, 32); if (e >= o) { pu += qu; pr += qr; } }
        if (lane < 32) { tab[e] = pu; tab[32 + e] = pr - te * 256; tab[64 + e] = ce; } }
    __syncthreads();
}
struct GroupedBase {
    static constexpr bool RAGGED = true;
    const LAS int* tab; int KB, G, vcu, NPN, ibase, lofs;
    __device__ __forceinline__ bool locate(int i, pg8::Unit& u) const {
        const int L = (i + ibase) * G + vcu + lofs, lane = threadIdx.x & 31;
        const int pre = tab[lane];
        const unsigned mask = (unsigned)__ballot(pre <= L);
        const int e = __builtin_popcount(mask);
        if (e >= NE) return false;
        const int excl = e ? __builtin_amdgcn_readfirstlane(tab[e - 1]) : 0, rowb = __builtin_amdgcn_readfirstlane(tab[32 + e]), ce = __builtin_amdgcn_readfirstlane(tab[64 + e]);
        const int l = L - excl, te = (ce + 255) >> 8, rt = l % te;
        u.pn = l / te; u.e = e; u.r0 = rt * 256; u.pm = (rowb >> 8) + rt; u.rowbase = rowb + rt * 256; u.rows = ce - rt * 256; u.half = 0; u.dep = te * NPN; return true;
    }
};
struct GateUp : GroupedBase {
    static constexpr bool WAITS = false, GATHER = true;
    const unsigned char* U2; const unsigned char* W; const int* perm;
    __device__ bool next(int i, pg8::Unit& u) const { return locate(i, u); }
    __device__ __forceinline__ const void* a_ptr() const { return U2; }
    __device__ __forceinline__ const void* b_ptr() const { return W; }
    __device__ __forceinline__ unsigned a_soff(const pg8::Unit&) const { return 0u; }
    __device__ __forceinline__ unsigned b_soff(const pg8::Unit& u) const { return ((unsigned)u.e * 2048u + (unsigned)u.pn * 256u) * 2048u; }
    __device__ __forceinline__ void a_off(const pg8::Unit& u, const unsigned (&)[2], const int (&stR)[2], const int (&stC)[2], unsigned (&o)[2][2]) const {
#pragma unroll
        for (int h = 0; h < 2; ++h)
#pragma unroll
            for (int i = 0; i < 2; ++i) { int rl = h * 128 + stR[i]; rl = rl < u.rows ? rl : u.rows - 1;
                const int tok = perm[(size_t)u.e * ECAP + u.r0 + rl]; o[h][i] = (unsigned)tok * 2048u + (unsigned)stC[i] * 2u; }
    }
};
struct EpiGateUp {
    static constexpr bool PERM = true, SIGNALS = true;
    unsigned char* ACT; const float* rstd; gu32* done;
    __device__ __forceinline__ void signal(int e) const { if (threadIdx.x == 0) (void)xb_add((unsigned*)(done + 16 * e), 1u); }
    __device__ __forceinline__ void prefetch(const pg8::Unit& u, int wr, int fr, float (&pre)[8]) const {
#pragma unroll
        for (int q = 0; q < 8; ++q) { const int rl = (q >> 2) * 128 + wr * 64 + (q & 3) * 16 + fr; pre[q] = rl < u.rows ? rstd[(size_t)u.e * ECAP + u.r0 + rl] : 0.f; }
    }
    __device__ __forceinline__ void operator()(const f32x4 (&acc)[2][2][4][2], const pg8::Unit& u, int wr, int wc, int fr_, int fq_, const float (&pre)[8]) const {
        int fr = fr_, fq = fq_; asm volatile("" : "+v"(fr), "+v"(fq));
        const int col0 = u.pn * 128 + wc * 32 + 8 * fq;
#pragma unroll
        for (int ai = 0; ai < 2; ++ai)
#pragma unroll
            for (int m = 0; m < 4; ++m) { const int rl = ai * 128 + wr * 64 + m * 16 + fr; const float rs = pre[ai * 4 + m] * (1.f / WSCALE8);
                float v[8];
#pragma unroll
                for (int n = 0; n < 2; ++n) { const f32x4 gt = acc[ai][0][m][n] * rs, up = acc[ai][1][m][n] * rs;
#pragma unroll
                    for (int j = 0; j < 4; ++j) v[4 * n + j] = gt[j] * __builtin_amdgcn_rcpf(1.0f + __expf(-gt[j])) * up[j]; }
                u32x2 w; w.x = pk4_fp8(v[0], v[1], v[2], v[3]); w.y = pk4_fp8(v[4], v[5], v[6], v[7]);
                __hip_atomic_store((GAS unsigned long long*)(ACT + (size_t)(u.rowbase + rl) * 1024 + col0), (unsigned long long)w.x | ((unsigned long long)w.y << 32), RLX_AGENT); }
    }
};
struct Down : GroupedBase {
    static constexpr bool WAITS = true, GATHER = false;
    const unsigned char* ACT; const unsigned char* W; gu32* done;
    __device__ __forceinline__ void wait_sync(const pg8::Unit& u, int& state) const {
        if (((unsigned)state >> u.e) & 1u) return;
        const int le = threadIdx.x & 31, ce = tab[64 + le], need = ((ce + 255) >> 8) * NPN;
        unsigned sp = 0u;
        for (;;) {
            const int have = (int)xb_ld((unsigned*)(done + 16 * le));
            const unsigned ok = (unsigned)__ballot(have >= need);
            state = (int)ok;
            if ((ok >> u.e) & 1u) break;
            __builtin_amdgcn_s_sleep(8); if (++sp > (1u << 20)) break;
        }
        asm volatile("" ::: "memory");
    }
    __device__ bool next(int i, pg8::Unit& u) const { return locate(i, u); }
    __device__ __forceinline__ const void* a_ptr() const { return ACT; }
    __device__ __forceinline__ const void* b_ptr() const { return W; }
    __device__ __forceinline__ unsigned a_soff(const pg8::Unit& u) const { return (unsigned)u.rowbase * 1024u; }
    __device__ __forceinline__ unsigned b_soff(const pg8::Unit& u) const { return ((unsigned)u.e * 2048u + (unsigned)u.pn * 256u) * 1024u; }
    __device__ __forceinline__ void a_off(const pg8::Unit&, const unsigned (&vA)[2], const int (&)[2], const int (&)[2], unsigned (&o)[2][2]) const {
        const unsigned hs = 128u * 1024u; o[0][0] = vA[0]; o[0][1] = vA[1]; o[1][0] = vA[0] + hs; o[1][1] = vA[1] + hs; }
};
struct EpiDown {
    static constexpr bool PERM = true, SIGNALS = false;
    bf16_t* YB; const float* gate;
    __device__ __forceinline__ void prefetch(const pg8::Unit&, int, int, float (&)[8]) const {}
    __device__ __forceinline__ void operator()(const f32x4 (&acc)[2][2][4][2], const pg8::Unit& u, int wr, int wc, int fr_, int fq_, const float (&pre)[8]) const {
        int fr = fr_, fq = fq_; asm volatile("" : "+v"(fr), "+v"(fq));
        const int col0 = u.pn * 256 + wc * 32 + 8 * fq;
#pragma unroll
        for (int ai = 0; ai < 2; ++ai)
#pragma unroll
            for (int m = 0; m < 4; ++m) { const int rl = ai * 128 + wr * 64 + m * 16 + fr; const float gs = 1.f / WSCALE8;
                bf16_t* rowp = YB + (size_t)(u.rowbase + rl) * 2048 + col0;
#pragma unroll
                for (int bj = 0; bj < 2; ++bj) { const f32x4 v0 = acc[ai][bj][m][0] * gs, v1 = acc[ai][bj][m][1] * gs;
                    u32x4 w; w.x = cvt_pk_bf16(v0[0], v0[1]); w.y = cvt_pk_bf16(v0[2], v0[3]); w.z = cvt_pk_bf16(v1[0], v1[1]); w.w = cvt_pk_bf16(v1[2], v1[3]);
                    *(u32x4*)(rowp + bj * 128) = w; } }
    }
};
__device__ __forceinline__ void p67_experts(const Args& a, LAS unsigned char* lds, int vcu, int G, const XcdBarrier& bar) {
    unsigned char* ws = a.ws;
    build_expert_tab((const gu32*)(ws + WS_CTL) + CW_CNT, lds, 8);
    const LAS int* tab = (const LAS int*)(lds + ETAB_OFF);
    gu32* done = (gu32*)(ws + WS_CTL) + CW_DONE;
    const int NU = __builtin_amdgcn_readfirstlane(tab[31]);
    {   GateUp S; S.tab = tab; S.KB = 2048; S.G = G; S.vcu = vcu; S.NPN = 8; S.ibase = 0; S.lofs = 0;
        S.U2 = ws + WS_U2; S.W = ws + WS_WGU; S.perm = (const int*)(ws + WS_SMALL + SM_PERM);
        EpiGateUp E{ws + WS_OALL, (const float*)(ws + WS_SMALL + SM_RSTD), done};
        pg8::gemm_phase<EpiGateUp, GateUp, true, true>(lds, S, E); }
#ifdef MK_SPLIT67
    xcd_barrier(bar);
#endif
    {   Down S; S.tab = tab; S.KB = 1024; S.G = G; S.vcu = vcu; S.NPN = 8; S.ibase = NU > vcu ? (NU - vcu + G - 1) / G : 0; S.lofs = -NU;
        S.ACT = ws + WS_OALL; S.W = ws + WS_WD; S.done = done;
        EpiDown E{(bf16_t*)(ws + WS_PROJ), (const float*)(ws + WS_SMALL + SM_GATE)};
        pg8::gemm_phase<EpiDown, Down, true, true>(lds, S, E); }
}
__device__ __forceinline__ void p8_final(const Args& a, LAS unsigned char* lds, int vcu, int G, int wave, int lane) {
    unsigned char* ws = a.ws;
    build_expert_tab((const gu32*)(ws + WS_CTL) + CW_CNT, lds, 8);
    const LAS int* RB = (const LAS int*)(lds + ETAB_OFF) + 32;
    const bf16_t* DLT = (const bf16_t*)(ws + WS_H); const bf16_t* YB = (const bf16_t*)(ws + WS_PROJ);
    const int* TOKE = (const int*)(ws + WS_SMALL + SM_TOKE); const int* TOKS = (const int*)(ws + WS_SMALL + SM_TOKS); const float* TOKG = (const float*)(ws + WS_SMALL + SM_GATE);
    const int gw = vcu * 8 + wave, NGW = G * 8;
    if (gw >= M) return;
    const int nrows = (M - gw + NGW - 1) / NGW;
    f32x4 gfv[8];
    { const GAS f32x4* gf = (const GAS f32x4*)a.in[I_GFINAL] + lane;
#pragma unroll
      for (int j = 0; j < 8; ++j) gfv[j] = gf[64 * j]; }
    struct Rec { int r0, r1; float g0, g1; };
    auto rowm = [&](int k) { return gw + (k < nrows ? k : nrows - 1) * NGW; };
    auto getrec = [&](int m) { Rec r; r.r0 = RB[TOKE[m * 2]] + TOKS[m * 2]; r.r1 = RB[TOKE[m * 2 + 1]] + TOKS[m * 2 + 1]; r.g0 = TOKG[m * 2]; r.g1 = TOKG[m * 2 + 1]; return r; };
    auto load = [&](int m, const Rec& rc, u32x2 (&d)[8], u32x2 (&pp)[8], u32x2 (&qq)[8]) {
        const GAS u32x2* dr = (const GAS u32x2*)(DLT + (size_t)m * 2048) + lane;
        const GAS u32x2* y0 = (const GAS u32x2*)(YB + (size_t)rc.r0 * 2048) + lane; const GAS u32x2* y1 = (const GAS u32x2*)(YB + (size_t)rc.r1 * 2048) + lane;
#pragma unroll
        for (int j = 0; j < 8; ++j) { d[j] = dr[64 * j]; pp[j] = y0[64 * j]; qq[j] = y1[64 * j]; } };
    auto finish = [&](int m, bool st, const Rec& rc, const u32x2 (&d)[8], const u32x2 (&pp)[8], const u32x2 (&qq)[8]) {
        const float g0 = rc.g0, g1 = rc.g1; f32x4 v[8]; float ss = 0.f;
#pragma unroll
        for (int j = 0; j < 8; ++j) {
            v[j].x = bflo(d[j].x) + g0 * bflo(pp[j].x) + g1 * bflo(qq[j].x); v[j].y = bfhi(d[j].x) + g0 * bfhi(pp[j].x) + g1 * bfhi(qq[j].x);
            v[j].z = bflo(d[j].y) + g0 * bflo(pp[j].y) + g1 * bflo(qq[j].y); v[j].w = bfhi(d[j].y) + g0 * bfhi(pp[j].y) + g1 * bfhi(qq[j].y);
            ss += (v[j].x * v[j].x + v[j].y * v[j].y) + (v[j].z * v[j].z + v[j].w * v[j].w); }
        const float rs = 1.0f / sqrtf(wave_sum(ss) * (1.f / D) + EPS);
        if (st) { GAS f32x4* o = (GAS f32x4*)(a.out + (size_t)m * 2048) + lane;
#pragma unroll
            for (int j = 0; j < 8; ++j) o[64 * j] = v[j] * rs * gfv[j]; } };
    u32x2 dA[8], dB[8], pA[8], pB[8], qA[8], qB[8];
    Rec rA = getrec(rowm(0)), rB = getrec(rowm(1));
    load(rowm(0), rA, dA, pA, qA);
    for (int k = 0; k < nrows; k += 2) {
        load(rowm(k + 1), rB, dB, pB, qB);
        const Rec rC = getrec(rowm(k + 2));
        finish(rowm(k), true, rA, dA, pA, qA);
        load(rowm(k + 2), rC, dA, pA, qA);
        const Rec rD = getrec(rowm(k + 3));
        finish(rowm(k + 1), k + 1 < nrows, rB, dB, pB, qB);
        rA = rC; rB = rD;
    }
}
}
namespace mk {
constexpr int NWAVES = 8;
constexpr int RING_BYTES = 131072, LDS_BYTES = 163840, CTLZ_OFF = LDS_BYTES - 1024, MISC_OFF = CTLZ_OFF + 320;
constexpr int NPHASE = 9;

__global__ void __launch_bounds__(NWAVES * 64, 2) mk_fwd(Args args) {
    extern __shared__ __attribute__((aligned(16))) unsigned char lds_raw[];
    LAS unsigned char* lds = (LAS unsigned char*)lds_raw;
    volatile LAS unsigned* MISC = (volatile LAS unsigned*)(lds + MISC_OFF);
    const int tid = threadIdx.x, lane = tid & 63, wave = __builtin_amdgcn_readfirstlane(tid >> 6);
    const int G = gridDim.x; const int bx = blockIdx.x; const int vcu = (G % 8 == 0) ? (bx % 8) * (G / 8) + bx / 8 : bx;
    unsigned char* ws = args.ws;
    gu32* ctl = (gu32*)(ws + WS_CTL);
    for (int u = tid; u < (LDS_BYTES - CTLZ_OFF) / 4; u += NWAVES * 64) ((LAS unsigned*)(lds + CTLZ_OFF))[u] = 0u;
    __syncthreads();
    const int lo = args.ph_lo, hi = args.ph_hi;
    const bool multi = (hi - lo) > 1;
    XcdBarrier bar; bar.bar = (unsigned*)(ctl + CW_BAR); bar.x = 0; bar.st = nullptr;
    if (multi) bar = xcd_barrier_post((unsigned*)(ctl + CW_BAR), MISC + 8);
#define IN(k) (lo <= (k) && (k) < hi)
#define SEAM(k) do { if (IN(k) && IN((k) + 1)) xcd_barrier(bar); } while (0)

#ifndef MK_GG
#define MK_GG 168
#endif
    const int GG = (G == 256) ? MK_GG : G;
#define PH0 { if (GG == G) { p0_prologue<3>(args, lds, vcu * 8 + wave, G * 8, wave, lane); p0_experts(args, lds, vcu * 8 + wave, G * 8, wave, lane); } \
      else p0_prologue<1>(args, lds, wave * G + vcu, G * 8, wave, lane); }
#define PH1 { if (bx < GG) { p1_meta(args, lds, bx, GG, wave, lane); \
        pg8::Dense S; S.init((const bf16_t*)(ws + WS_XN), (const bf16_t*)(ws + WS_WIN), M, DIN, D, GG, bx); \
        EpiProj E{ws + WS_PROJ}; pg8::gemm_phase<EpiProj, pg8::Dense, true>(lds, S, E); } \
      else { p0_prologue<2>(args, lds, (bx - GG) * 8 + wave, (G - GG) * 8, wave, lane); p0_experts(args, lds, (bx - GG) * 8 + wave, (G - GG) * 8, wave, lane); } }
#define PH2 { p2_attn_lru(args, lds, lds_raw, vcu, G, wave, lane); }
#define PH3 { p3_combine(args, lds, vcu, G, wave, lane); }
#define PH4 { pg8::Dense S; S.init((const bf16_t*)(ws + WS_MIX), (const bf16_t*)(ws + WS_WOUT), M, D, D, G, bx); \
        EpiH E{(bf16_t*)(ws + WS_H), (const bf16_t*)(ws + WS_XN), (const float*)(ws + WS_SMALL + SM_XRMS), (const float*)(ws + WS_SMALL + SM_GINV), ws + WS_U2, args.in[I_GFFN]}; pg8::gemm_phase<EpiH, pg8::Dense, true>(lds, S, E); }
#define PH5 { p5_router(args, lds, vcu, G, wave, lane); }
#define PH6 { p67_experts(args, lds, vcu, G, bar); }
#define PH7 { }
#define PH8 { p8_final(args, lds, vcu, G, wave, lane); }
#ifndef MK_REPEAT
#define MK_REPEAT -1
#endif
#define RUN(k, BODY) do { if (IN(k)) { BODY if (MK_REPEAT == (k)) { __syncthreads(); BODY } } SEAM(k); } while (0)
    RUN(0, PH0); RUN(1, PH1); RUN(2, PH2);   RUN(4, PH4);
#ifdef MK_EXTRA_BAR
    if (multi) for (int xb_ = 0; xb_ < MK_EXTRA_BAR; ++xb_) xcd_barrier(bar);
#endif
    RUN(5, PH5); RUN(6, PH6);
    if (IN(8)) { PH8 if (MK_REPEAT == 8) { __syncthreads(); PH8 } }
#undef IN
#undef SEAM
}

static int mk_grid() {
    static int grid = 0;
    if (grid == 0) {
        int dev = 0, cus = 0, per_cu = 0;
        (void)hipGetDevice(&dev); (void)hipDeviceGetAttribute(&cus, hipDeviceAttributeMultiprocessorCount, dev);
        (void)hipFuncSetAttribute((const void*)mk_fwd, hipFuncAttributeMaxDynamicSharedMemorySize, LDS_BYTES);
        (void)hipOccupancyMaxActiveBlocksPerMultiprocessor(&per_cu, (const void*)mk_fwd, NWAVES * 64, LDS_BYTES);
        (void)hipGetLastError();
        if (per_cu < 1) per_cu = 1;
        grid = cus * 1;
        if (grid <= 0) grid = 256;
    }
    return grid;
}
static void mk_launch(void* const* d_in, float* out, unsigned char* ws, int lo, int hi, hipStream_t stream) {
    Args a{}; for (int i = 0; i < 27; ++i) a.in[i] = (const float*)d_in[i];
    a.out = out; a.ws = ws; a.ph_lo = lo; a.ph_hi = hi;
    hipLaunchKernelGGL(mk_fwd, dim3(mk_grid()), dim3(NWAVES * 64), LDS_BYTES, stream, a);
}
}
extern "C" void kernel_launch(void* const* d_in, const int* in_sizes, int n_in, void* d_out, int out_size, void* d_ws, size_t ws_size, hipStream_t stream) {
    (void)in_sizes; (void)n_in; (void)out_size; (void)ws_size;
    unsigned char* ws = (unsigned char*)d_ws;
    (void)hipMemsetAsync(ws + mk::WS_CTL, 0, mk::CTL_ZERO_BYTES, stream);
#if MK_ONE_LAUNCH
    mk::mk_launch(d_in, (float*)d_out, ws, 0, mk::NPHASE, stream);
#else
    for (int p = 0; p < mk::NPHASE; ++p) mk::mk_launch(d_in, (float*)d_out, ws, p, p + 1, stream);
#endif
}
```
